# Optimizing an MI355X kernel written in HIP

```python
import math
import jax, jax.numpy as jnp
from jax import lax
import numpy as np

D_MODEL = 1024
BATCH = 2
SEQ = 8192
DEPTH = 1

SSD_HEADS = 16
SSD_HEAD_DIM = 64
SSD_WIDTH = SSD_HEADS * SSD_HEAD_DIM
SSD_GROUPS = 4
SSD_STATE = 128
SSD_CONV = 4
SSD_CHUNK = 256
S5_GROUP_DIM = 16
S5_GROUPS = 32
S5_WIDTH = S5_GROUPS * S5_GROUP_DIM
S5_STATE = 64
MIX_WIDTH = SSD_WIDTH + S5_WIDTH
CONV_DIM = SSD_WIDTH + 2 * SSD_GROUPS * SSD_STATE
IN_PROJ = SSD_WIDTH + CONV_DIM + SSD_HEADS + S5_WIDTH
N_EXPERTS = 256
TOP_K = 8
N_EXPERT_GROUPS = 8
TOPK_GROUPS = 4
EXPERT_FF = 256
SHARED_FF = 256
ROUTED_SCALE = 2.5
MOE_BLOCK = 128
N_MOD = 6
EPS = 1e-6

kernel_name = "hymba_ssd_s5_moe_adaln_block"


def rms_norm(x, gain):
    xf = x.astype(jnp.float32)
    y = xf * lax.rsqrt(jnp.mean(xf * xf, axis=-1, keepdims=True) + EPS)
    return (y * gain.astype(jnp.float32)).astype(x.dtype)


def causal_depthwise_conv(x, w, b):
    ch = x.shape[-1]
    out = lax.conv_general_dilated(x, w[:, None, :].astype(x.dtype), window_strides=(1,),
                                   padding=[(SSD_CONV - 1, 0)],
                                   dimension_numbers=("NWC", "WIO", "NWC"),
                                   feature_group_count=ch)
    return out + b


def ssd_chunked(xdt, a, bm, cm):
    bsz, seq, n_heads, hd = xdt.shape
    n_grp, n_state = bm.shape[-2:]
    hpg = n_heads // n_grp
    pad = (-seq) % SSD_CHUNK
    if pad:
        xdt = jnp.pad(xdt, ((0, 0), (0, pad), (0, 0), (0, 0)))
        a = jnp.pad(a, ((0, 0), (0, pad), (0, 0)))
        bm = jnp.pad(bm, ((0, 0), (0, pad), (0, 0), (0, 0)))
        cm = jnp.pad(cm, ((0, 0), (0, pad), (0, 0), (0, 0)))
    n_chunks = (seq + pad) // SSD_CHUNK
    x = xdt.reshape(bsz, n_chunks, SSD_CHUNK, n_grp, hpg, hd)
    a = a.reshape(bsz, n_chunks, SSD_CHUNK, n_grp, hpg).transpose(0, 3, 4, 1, 2)
    bm = bm.reshape(bsz, n_chunks, SSD_CHUNK, n_grp, n_state)
    cm = cm.reshape(bsz, n_chunks, SSD_CHUNK, n_grp, n_state)
    a_cs = jnp.cumsum(a, axis=-1)
    causal = jnp.tril(jnp.ones((SSD_CHUNK, SSD_CHUNK), dtype=bool))
    seg = a_cs[..., :, None] - a_cs[..., None, :]
    decay_ls = jnp.exp(jnp.where(causal, seg, -jnp.inf))
    scores = jnp.einsum("bclgn,bcsgn->bgcls", cm, bm)
    y_diag = jnp.einsum("bghcls,bcsghp->bclghp", scores[:, :, None] * decay_ls, x)
    decay_states = jnp.exp(a_cs[..., -1:] - a_cs)
    states = jnp.einsum("bclgn,bghcl,bclghp->bcghpn", bm, decay_states, x)
    a_tot = a_cs[..., -1]

    def chunk_step(h, inp):
        st, at = inp
        return jnp.exp(at)[..., None, None] * h + st, h

    h0 = jnp.zeros(states.shape[:1] + states.shape[2:], states.dtype)
    _, prev_states = lax.scan(chunk_step, h0,
                              (states.transpose(1, 0, 2, 3, 4, 5), a_tot.transpose(3, 0, 1, 2)))
    y_off = jnp.einsum("bclgn,cbghpn,bghcl->bclghp", cm, prev_states, jnp.exp(a_cs))
    y = (y_diag + y_off).reshape(bsz, n_chunks * SSD_CHUNK, n_heads, hd)
    return y[:, :seq]


def s5_scan(u, a_re, a_im, log_dt, b_re, b_im, c_re, c_im, d_skip):
    f32 = jnp.float32
    u = u.astype(f32)
    dt = jnp.exp(log_dt.astype(f32))[:, None]
    lam_re = jnp.minimum(a_re.astype(f32), -1e-4)
    lam_im = a_im.astype(f32)
    mag = jnp.exp(lam_re * dt)
    ab_re = mag * jnp.cos(lam_im * dt)
    ab_im = mag * jnp.sin(lam_im * dt)
    den = lam_re * lam_re + lam_im * lam_im
    num_re = ab_re - 1.0
    f_re = (num_re * lam_re + ab_im * lam_im) / den
    f_im = (ab_im * lam_re - num_re * lam_im) / den
    b_re = b_re.astype(f32)
    b_im = b_im.astype(f32)
    bb_re = f_re[..., None] * b_re - f_im[..., None] * b_im
    bb_im = f_re[..., None] * b_im + f_im[..., None] * b_re
    bu_re = jnp.einsum("blgp,gnp->blgn", u, bb_re)
    bu_im = jnp.einsum("blgp,gnp->blgn", u, bb_im)
    a_full_re = jnp.broadcast_to(ab_re, bu_re.shape)
    a_full_im = jnp.broadcast_to(ab_im, bu_im.shape)

    def combine(e1, e2):
        a1r, a1i, b1r, b1i = e1
        a2r, a2i, b2r, b2i = e2
        return (a2r * a1r - a2i * a1i,
                a2r * a1i + a2i * a1r,
                a2r * b1r - a2i * b1i + b2r,
                a2r * b1i + a2i * b1r + b2i)

    _, _, s_re, s_im = lax.associative_scan(combine, (a_full_re, a_full_im, bu_re, bu_im), axis=1)
    y = (jnp.einsum("gpn,blgn->blgp", c_re.astype(f32), s_re)
         - jnp.einsum("gpn,blgn->blgp", c_im.astype(f32), s_im))
    return y + d_skip.astype(f32) * u


def hybrid_mixer(h, w_in, conv_w, conv_b, dt_bias, ssd_a_log, ssd_d, ssd_norm_gain,
                 s5_a_re, s5_a_im, s5_log_dt, s5_b_re, s5_b_im, s5_c_re, s5_c_im, s5_d,
                 w_glu, b_glu, s5_norm_gain, w_out):
    f32 = jnp.float32
    bsz, seq, _ = h.shape
    proj = h @ w_in
    z, xbc, dt_raw, u = jnp.split(proj, [SSD_WIDTH, SSD_WIDTH + CONV_DIM,
                                         SSD_WIDTH + CONV_DIM + SSD_HEADS], axis=-1)
    xbc = jax.nn.silu(causal_depthwise_conv(xbc, conv_w, conv_b))
    xs, bm, cm = jnp.split(xbc, [SSD_WIDTH, SSD_WIDTH + SSD_GROUPS * SSD_STATE], axis=-1)
    xs = xs.reshape(bsz, seq, SSD_HEADS, SSD_HEAD_DIM)
    bm = bm.reshape(bsz, seq, SSD_GROUPS, SSD_STATE).astype(f32)
    cm = cm.reshape(bsz, seq, SSD_GROUPS, SSD_STATE).astype(f32)
    dt = jax.nn.softplus((dt_raw + dt_bias).astype(f32))
    a = -jnp.exp(ssd_a_log.astype(f32))
    y = ssd_chunked(xs.astype(f32) * dt[..., None], dt * a, bm, cm)
    y = y + ssd_d.astype(f32)[:, None] * xs.astype(f32)
    y = y.reshape(bsz, seq, SSD_WIDTH).astype(h.dtype)
    y_ssd = rms_norm(y * jax.nn.silu(z), ssd_norm_gain)
    y5 = s5_scan(u.reshape(bsz, seq, S5_GROUPS, S5_GROUP_DIM), s5_a_re, s5_a_im, s5_log_dt,
                 s5_b_re, s5_b_im, s5_c_re, s5_c_im, s5_d.reshape(S5_GROUPS, S5_GROUP_DIM))
    g = jax.nn.gelu(y5.reshape(bsz, seq, S5_WIDTH).astype(h.dtype))
    y5 = g * jax.nn.sigmoid(g @ w_glu + b_glu)
    y_s5 = rms_norm(y5, s5_norm_gain)
    return jnp.concatenate([y_ssd, y_s5], axis=-1) @ w_out


def swiglu(x, w1, w3, w2):
    return (jax.nn.silu(x @ w1) * (x @ w3)) @ w2


def route(h, w_router, router_bias):
    f32 = jnp.float32
    n_tok = h.shape[0]
    scores = jax.nn.sigmoid((h @ w_router).astype(f32))
    biased = scores + router_bias.astype(f32)
    grp = biased.reshape(n_tok, N_EXPERT_GROUPS, N_EXPERTS // N_EXPERT_GROUPS)
    grp_score = lax.top_k(grp, 2)[0].sum(-1)
    _, gidx = lax.top_k(grp_score, TOPK_GROUPS)
    gmask = (gidx[..., None] == jnp.arange(N_EXPERT_GROUPS)).any(-2)
    masked = jnp.where(gmask[..., None], grp, -jnp.inf).reshape(n_tok, N_EXPERTS)
    _, eidx = lax.top_k(masked, TOP_K)
    w = jnp.take_along_axis(scores, eidx, axis=-1)
    w = w / jnp.sum(w, axis=-1, keepdims=True) * ROUTED_SCALE
    return eidx, w


def routed_experts(h, eidx, gate_w, w1, w3, w2):
    n_tok, d = h.shape
    n_assign = n_tok * TOP_K
    n_blocks = (n_assign + N_EXPERTS * (MOE_BLOCK - 1) + MOE_BLOCK - 1) // MOE_BLOCK
    flat_e = eidx.reshape(-1)
    flat_t = jnp.repeat(jnp.arange(n_tok, dtype=jnp.int32), TOP_K)
    flat_w = gate_w.reshape(-1)
    order = jnp.argsort(flat_e)
    se, st, sw = flat_e[order], flat_t[order], flat_w[order]
    counts = jnp.bincount(flat_e, length=N_EXPERTS)
    padded = (counts + MOE_BLOCK - 1) // MOE_BLOCK * MOE_BLOCK
    pad_end = jnp.cumsum(padded)
    pad_start = pad_end - padded
    start = jnp.cumsum(counts) - counts
    dest = pad_start[se] + jnp.arange(n_assign, dtype=jnp.int32) - start[se]
    tok_buf = jnp.full((n_blocks * MOE_BLOCK,), n_tok, jnp.int32).at[dest].set(st)
    w_buf = jnp.zeros((n_blocks * MOE_BLOCK,), sw.dtype).at[dest].set(sw)
    block_e = jnp.minimum(jnp.searchsorted(pad_end, jnp.arange(n_blocks, dtype=jnp.int32) * MOE_BLOCK,
                                           side="right"), N_EXPERTS - 1)
    h_pad = jnp.concatenate([h, jnp.zeros((1, d), h.dtype)], axis=0)

    def expert_block(args):
        tok, wt, e = args
        xb = h_pad[tok]
        return swiglu(xb, w1[e], w3[e], w2[e]) * wt[:, None].astype(h.dtype)

    out = lax.map(expert_block, (tok_buf.reshape(n_blocks, MOE_BLOCK),
                                 w_buf.reshape(n_blocks, MOE_BLOCK), block_e))
    return jax.ops.segment_sum(out.reshape(-1, d), tok_buf, num_segments=n_tok + 1)[:n_tok]


def setup_inputs(seed: int = 0) -> dict:
    key = jax.random.key(seed)
    ks = jax.random.split(key, 40)
    f32 = jnp.float32

    def nrm(k, shape, scale):
        return jax.random.normal(k, shape, f32) * scale

    L = DEPTH
    dt0 = jnp.exp(jax.random.uniform(ks[6], (L, SSD_HEADS), f32, math.log(1e-3), math.log(1e-1)))
    n_idx = jnp.arange(S5_STATE, dtype=f32)
    return {
        "x": nrm(ks[0], (BATCH, SEQ, D_MODEL), 1.0),
        "c": nrm(ks[1], (BATCH, D_MODEL), 1.0),
        "w_ada": nrm(ks[2], (L, D_MODEL, N_MOD * D_MODEL), 0.5 * D_MODEL ** -0.5),
        "b_ada": nrm(ks[3], (L, N_MOD * D_MODEL), 0.02),
        "norm1_gain": 1.0 + nrm(ks[4], (L, D_MODEL), 0.02),
        "w_in": nrm(ks[5], (L, D_MODEL, IN_PROJ), D_MODEL ** -0.5),
        "conv_w": nrm(ks[7], (L, SSD_CONV, CONV_DIM), SSD_CONV ** -0.5),
        "conv_b": nrm(ks[8], (L, CONV_DIM), 0.02),
        "dt_bias": dt0 + jnp.log(-jnp.expm1(-dt0)),
        "ssd_a_log": jnp.log(jax.random.uniform(ks[9], (L, SSD_HEADS), f32, 1.0, 16.0)),
        "ssd_d": 1.0 + nrm(ks[10], (L, SSD_HEADS), 0.1),
        "ssd_norm_gain": 1.0 + nrm(ks[11], (L, SSD_WIDTH), 0.02),
        "s5_a_re": -0.5 + nrm(ks[12], (L, S5_GROUPS, S5_STATE), 0.01),
        "s5_a_im": math.pi * n_idx + nrm(ks[13], (L, S5_GROUPS, S5_STATE), 0.01),
        "s5_log_dt": jax.random.uniform(ks[14], (L, S5_GROUPS), f32, math.log(1e-3), math.log(1e-1)),
        "s5_b_re": nrm(ks[15], (L, S5_GROUPS, S5_STATE, S5_GROUP_DIM), (2 * S5_GROUP_DIM) ** -0.5),
        "s5_b_im": nrm(ks[16], (L, S5_GROUPS, S5_STATE, S5_GROUP_DIM), (2 * S5_GROUP_DIM) ** -0.5),
        "s5_c_re": nrm(ks[17], (L, S5_GROUPS, S5_GROUP_DIM, S5_STATE), (2 * S5_STATE) ** -0.5),
        "s5_c_im": nrm(ks[18], (L, S5_GROUPS, S5_GROUP_DIM, S5_STATE), (2 * S5_STATE) ** -0.5),
        "s5_d": nrm(ks[19], (L, S5_WIDTH), 1.0),
        "w_glu": nrm(ks[20], (L, S5_WIDTH, S5_WIDTH), S5_WIDTH ** -0.5),
        "b_glu": nrm(ks[21], (L, S5_WIDTH), 0.02),
        "s5_norm_gain": 1.0 + nrm(ks[22], (L, S5_WIDTH), 0.02),
        "w_out": nrm(ks[23], (L, MIX_WIDTH, D_MODEL), MIX_WIDTH ** -0.5),
        "norm2_gain": 1.0 + nrm(ks[24], (L, D_MODEL), 0.02),
        "w_router": nrm(ks[25], (L, D_MODEL, N_EXPERTS), D_MODEL ** -0.5),
        "router_bias": nrm(ks[26], (L, N_EXPERTS), 0.01),
        "w1": nrm(ks[27], (L, N_EXPERTS, D_MODEL, EXPERT_FF), D_MODEL ** -0.5),
        "w3": nrm(ks[28], (L, N_EXPERTS, D_MODEL, EXPERT_FF), D_MODEL ** -0.5),
        "w2": nrm(ks[29], (L, N_EXPERTS, EXPERT_FF, D_MODEL), EXPERT_FF ** -0.5),
        "ws1": nrm(ks[30], (L, D_MODEL, SHARED_FF), D_MODEL ** -0.5),
        "ws3": nrm(ks[31], (L, D_MODEL, SHARED_FF), D_MODEL ** -0.5),
        "ws2": nrm(ks[32], (L, SHARED_FF, D_MODEL), SHARED_FF ** -0.5),
        "final_gain": 1.0 + nrm(ks[33], (D_MODEL,), 0.02),
    }


def reference(x, c, w_ada, b_ada, norm1_gain, w_in, conv_w, conv_b, dt_bias, ssd_a_log, ssd_d,
              ssd_norm_gain, s5_a_re, s5_a_im, s5_log_dt, s5_b_re, s5_b_im, s5_c_re, s5_c_im, s5_d,
              w_glu, b_glu, s5_norm_gain, w_out, norm2_gain, w_router, router_bias, w1, w3, w2,
              ws1, ws3, ws2, final_gain):
    bsz, seq, d = x.shape
    c_act = jax.nn.silu(c)
    for i in range(DEPTH):
        mod = c_act @ w_ada[i] + b_ada[i]
        sh1, sc1, g1, sh2, sc2, g2 = jnp.split(mod[:, None, :], N_MOD, axis=-1)
        h = rms_norm(x, norm1_gain[i]) * (1.0 + sc1) + sh1
        mix = hybrid_mixer(h, w_in[i], conv_w[i], conv_b[i], dt_bias[i], ssd_a_log[i], ssd_d[i],
                           ssd_norm_gain[i], s5_a_re[i], s5_a_im[i], s5_log_dt[i], s5_b_re[i],
                           s5_b_im[i], s5_c_re[i], s5_c_im[i], s5_d[i], w_glu[i], b_glu[i],
                           s5_norm_gain[i], w_out[i])
        x = x + g1 * mix
        h = rms_norm(x, norm2_gain[i]) * (1.0 + sc2) + sh2
        hf = h.reshape(bsz * seq, d)
        eidx, gate_w = route(hf, w_router[i], router_bias[i])
        y = swiglu(hf, ws1[i], ws3[i], ws2[i]) + routed_experts(hf, eidx, gate_w, w1[i], w3[i], w2[i])
        x = x + g2 * y.reshape(bsz, seq, d)
    return rms_norm(x, final_gain)
```

```cpp
#include <hip/hip_runtime.h>
#include <stdint.h>
#include <stdio.h>
#include <string.h>

#ifndef MULTI_LAUNCH
#define MULTI_LAUNCH 0
#endif
#ifndef MAX_PHASE
#define MAX_PHASE 99
#endif
#ifndef REPEAT_PHASE
#define REPEAT_PHASE -1
#endif
#ifndef PROBE_VARIANT
#define PROBE_VARIANT 0
#endif

#define DEV __device__ __forceinline__
#define LAS __attribute__((address_space(3)))
typedef unsigned short bf16_t;
typedef short bf16x8 __attribute__((ext_vector_type(8)));
typedef float f32x4 __attribute__((ext_vector_type(4)));
typedef unsigned u32x2 __attribute__((ext_vector_type(2)));
typedef unsigned u32x4 __attribute__((ext_vector_type(4)));

__device__ __forceinline__ unsigned tid_v_() { unsigned t = __builtin_amdgcn_workitem_id_x(); asm volatile("" : "+v"(t)); return t; }
#define TIDX (tid_v_())

constexpr int T_TOK = 16384, SEQ = 8192, DM = 1024;
constexpr int NPROJ = 3600, NPROJ_PAD = 3712;
constexpr int NEXP = 256, CAP = 16384, NSLOT = T_TOK * 8;
constexpr int S5Q = 32;
constexpr int NPHASE = 13;

typedef __bf16 hbf2 __attribute__((ext_vector_type(2)));
typedef float f32x2 __attribute__((ext_vector_type(2)));
DEV bf16_t f2bf(float f) { const __bf16 b = (__bf16)f; return __builtin_bit_cast(bf16_t, b); }
DEV float bf2f(bf16_t h) { return __uint_as_float(((unsigned)h) << 16); }
DEV unsigned pack2(float lo, float hi) { const f32x2 v = {lo, hi}; const hbf2 b = __builtin_convertvector(v, hbf2); return __builtin_bit_cast(unsigned, b); }
DEV float sigmoidf_(float v) { return __builtin_amdgcn_rcpf(1.f + __expf(-v)); }
DEV float siluf_(float v) { return v * __builtin_amdgcn_rcpf(1.f + __expf(-v)); }
DEV float gelu_tanh(float v) { float u = 0.7978845608028654f * (v + 0.044715f * v * v * v); float th = 1.f - 2.f * __builtin_amdgcn_rcpf(1.f + __expf(2.f * u)); return 0.5f * v * (1.f + th); }
DEV float wave_sum(float v) {
#pragma unroll
    for (int o = 32; o >= 1; o >>= 1) v += __shfl_xor(v, o);
    return v;
}

#define XB_TMO      128
#define XB_XCNT(j)  (256  + 64 * (j))
#define XB_XSUB(j)  (1280 + 64 * (j))
#define XB_XGEN(j)  (2304 + 64 * (j))
#define XB_TOP      3328
#define XB_TOPGEN   3392
#define XCD_BAR_WORDS 3456
#define XB_SPIN_CAP (1u << 20)
DEV unsigned xb_ld(unsigned* p) { return __hip_atomic_load(p, __ATOMIC_RELAXED, __HIP_MEMORY_SCOPE_AGENT); }
DEV unsigned xb_add(unsigned* p, unsigned v) { return __hip_atomic_fetch_add(p, v, __ATOMIC_RELAXED, __HIP_MEMORY_SCOPE_AGENT); }
DEV unsigned xb_xcc_id() { return (unsigned)__builtin_amdgcn_s_getreg((3 << 11) | 20) & 0xFu; }
#define XB_SPIN(cond, bar) do { unsigned _sp = 0; while (cond) { __builtin_amdgcn_s_sleep(1); \
    if ((++_sp & 255u) == 0u) { if (xb_ld(&(bar)[XB_TMO])) break; if (_sp > XB_SPIN_CAP) { atomicAdd(&(bar)[XB_TMO], 1u); break; } } } } while (0)
struct XcdBarrier { unsigned* bar; unsigned x; volatile LAS unsigned* st; };
DEV XcdBarrier xcd_barrier_post(unsigned* bar, volatile LAS unsigned* st) {
    XcdBarrier b; b.bar = bar; b.x = xb_xcc_id(); b.st = st;
    if (TIDX == 0) (void)xb_add(&bar[XB_XCNT(b.x)], 1u);
    return b;
}
DEV void xcd_barrier_complete(unsigned* bar, unsigned x, unsigned& nloc, unsigned& nx) {
    const unsigned G = gridDim.x * gridDim.y * gridDim.z;
    unsigned sum, cnt, mine, sp = 0u;
    for (;;) {
        sum = 0u; cnt = 0u; mine = 0u;
#pragma unroll
        for (unsigned j = 0; j < 16; ++j) { const unsigned c = xb_ld(&bar[XB_XCNT(j)]); sum += c; cnt += (c > 0u) ? 1u : 0u; mine = (j == x) ? c : mine; }
        if (sum == G) break;
        __builtin_amdgcn_s_sleep(1);
        if ((++sp & 255u) == 0u) { if (xb_ld(&bar[XB_TMO])) break; if (sp > XB_SPIN_CAP) { atomicAdd(&bar[XB_TMO], 1u); break; } }
    }
    nloc = mine > 0u ? mine : 1u; nx = cnt > 0u ? cnt : 1u;
}
DEV void xcd_barrier(const XcdBarrier& b) {
    asm volatile("s_waitcnt vmcnt(0)" ::: "memory");
    __syncthreads();
    if (TIDX == 0) {
        unsigned* bar = b.bar;
        __builtin_amdgcn_s_waitcnt(0);
        unsigned nloc = b.st[0], nx = b.st[1];
        if (nloc == 0u) { xcd_barrier_complete(bar, b.x, nloc, nx); b.st[0] = nloc; b.st[1] = nx; }
        const unsigned old = xb_add(&bar[XB_XSUB(b.x)], 1u);
        const unsigned gen = old / nloc;
        if (old + 1u == (gen + 1u) * nloc) {
            __builtin_amdgcn_fence(__ATOMIC_RELEASE, "agent");
            asm volatile("s_waitcnt vmcnt(0)" ::: "memory");
            const unsigned og = xb_add(&bar[XB_TOP], 1u);
            const unsigned tg = og / nx;
            if (og + 1u == (tg + 1u) * nx) xb_add(&bar[XB_TOPGEN], 1u);
            else XB_SPIN(xb_ld(&bar[XB_TOPGEN]) == tg, bar);
            __builtin_amdgcn_fence(__ATOMIC_ACQUIRE, "agent");
            xb_add(&bar[XB_XGEN(b.x)], 1u);
            asm volatile("s_waitcnt vmcnt(0)" ::: "memory");
        } else {
            XB_SPIN(xb_ld(&bar[XB_XGEN(b.x)]) == gen, bar);
            __builtin_amdgcn_fence(__ATOMIC_ACQUIRE, "agent");
            asm volatile("s_waitcnt vmcnt(0)" ::: "memory");
        }
    }
    __syncthreads();
}

struct Params {
    const float *x, *c, *w_ada, *b_ada, *norm1_gain, *w_in, *conv_w, *conv_b, *dt_bias, *ssd_a_log, *ssd_d, *ssd_norm_gain,
        *s5_a_re, *s5_a_im, *s5_log_dt, *s5_b_re, *s5_b_im, *s5_c_re, *s5_c_im, *s5_d, *w_glu, *b_glu, *s5_norm_gain, *w_out,
        *norm2_gain, *w_router, *router_bias, *w1, *w3, *w2, *ws1, *ws3, *ws2, *final_gain;
    float* out;
    unsigned* bar;
    float* MOD;
    bf16_t* H;
    bf16_t* WINT;
    bf16_t* WOUTT;
    bf16_t* WGLUT;
    bf16_t* WRT;
    bf16_t* WSUPT;
    bf16_t* WS2T;
    float* KERN;
    bf16_t* W5T;
    bf16_t* E5T;
    float* AQ;
    bf16_t* Z;
    bf16_t* XBCR;
    float* DTR;
    bf16_t* UG;
    bf16_t* XN;
    bf16_t* BN;
    bf16_t* CN;
    bf16_t* XDTT;
    bf16_t* XDECT;
    bf16_t* BT;
    float* ACS;
    float* ST;
    bf16_t* PREV;
    float* E5;
    bf16_t* SPREV;
    bf16_t* G5;
    bf16_t* Y5;
    bf16_t* YG;
    float* SSQ;
    int* CNT;
    float* X1;
    float* SCORES;
    int* BTOK;
    int* ASG_E;
    int* ASG_P;
    float* ASG_W;
    bf16_t* HSH;
    bf16_t* HID;
    bf16_t* OUTR;
    float* DBG;
    int phase_lo, phase_hi, repeat_phase, pad_;
};

typedef const __attribute__((address_space(4))) Params CParams;

constexpr int BK = 32, ST_A = 256 * 64, ST_B = 128 * 64, STAGE_B = ST_A + ST_B;
constexpr int GEMM_SMEM = 3 * STAGE_B;
constexpr int SMEM_BYTES = GEMM_SMEM + 4096;
DEV unsigned tid_opaque() { unsigned t = __builtin_amdgcn_workitem_id_x(); asm volatile("" : "+v"(t)); return t; }
DEV long pkl(long r, int k, int KB) { return (((r >> 1) * KB + (k >> 5)) << 6) + ((r & 1) << 5) + (k & 31); }
DEV int bcol(int R) { return (R & 64) | (((R >> 2) & 3) << 4) | (((R >> 4) & 3) << 2) | (R & 3); }
DEV int swzF(int kc) { return (0x9C >> (2 * kc)) & 3; }
DEV int swzFinv(int c) { return (0x78 >> (2 * c)) & 3; }

template <int NI> struct GRow {
    const bf16_t* p0; long s64;
    DEV void init(const bf16_t* base, long ld, bool perm) {
        const int tid = TIDX, r0 = tid >> 2, kcs = swzFinv((tid & 3) ^ ((tid >> 4) & 3));
        p0 = base + (long)(perm ? bcol(r0) : r0) * ld + kcs * 8; s64 = 64 * ld; kst = BK;
    }
    int kst;
    DEV void initp(const bf16_t* base, int KB, long row0, bool perm, int kt0 = 0) {
        const int tid = TIDX, r0 = tid >> 2, kcs = swzFinv((tid & 3) ^ ((tid >> 4) & 3));
        const int r = perm ? bcol(r0) : r0;
        p0 = base + pkl(row0 + r, kt0 * 32, KB) + kcs * 8; s64 = (long)32 * KB * 64; kst = 64;
    }
    DEV void issue(int kt, char* img) {
        char* d = img + (TIDX >> 6) * 1024;
#pragma unroll
        for (int i = 0; i < NI; ++i) __builtin_amdgcn_global_load_lds((const unsigned*)(p0 + i * s64 + (long)kt * kst), (unsigned*)(d + i * 4096), 16, 0, 0);
    }
};
struct GGather {
    const char* base; unsigned off[4];
    DEV void issue(int kt, char* img) {
        char* d = img + (TIDX >> 6) * 1024;
#pragma unroll
        for (int i = 0; i < 4; ++i) __builtin_amdgcn_global_load_lds((const unsigned*)(base + (size_t)(off[i] + (unsigned)(kt * BK * 2))), (unsigned*)(d + i * 4096), 16, 0, 0);
    }
};
DEV int gather_kcs() { return swzFinv((TIDX & 3) ^ ((TIDX >> 4) & 3)) * 8; }
template <int LDN> struct ColF32 {
    const float* colp; f32x4 v[4];
    DEV void load(int kt) {
        const float* q = colp + (long)(kt * BK + (tid_opaque() >> 5) * 4) * LDN;
#pragma unroll
        for (int e = 0; e < 4; ++e) v[e] = *(const f32x4*)(q + (long)e * LDN);
    }
    DEV void store(char* img) {
        const unsigned t_ = tid_opaque(); const int R0 = (t_ & 31) * 4, ksub = t_ >> 5, kc = ksub >> 1, half = ksub & 1;
#pragma unroll
        for (int c = 0; c < 4; ++c) {
            const int row = R0 + c;
            u32x2 w; w.x = pack2(v[0][c], v[1][c]); w.y = pack2(v[2][c], v[3][c]);
            *(u32x2*)(img + row * 64 + ((((row >> 2) & 3) ^ swzF(kc)) * 16) + half * 8) = w;
        }
    }
};
DEV void zero_acc(f32x4 (&acc)[8][4]) {
#pragma unroll
    for (int m = 0; m < 8; ++m)
#pragma unroll
        for (int n = 0; n < 4; ++n) acc[m][n] = (f32x4){0.f, 0.f, 0.f, 0.f};
}
template <bool PF> DEV void mma_stage(const char* st, int aoff, int boff, f32x4 (&acc)[8][4]) {
    bf16x8 bf[4];
#pragma unroll
    for (int n = 0; n < 4; ++n) bf[n] = *(const bf16x8*)(st + ST_A + boff + n * 1024);
    bf16x8 a0 = *(const bf16x8*)(st + aoff), a1 = *(const bf16x8*)(st + aoff + 1024);
#pragma unroll
    for (int mp = 0; mp < 4; ++mp) {
        bf16x8 n0 = a0, n1 = a1;
        if (mp < 3) { n0 = *(const bf16x8*)(st + aoff + (2 * mp + 2) * 1024); n1 = *(const bf16x8*)(st + aoff + (2 * mp + 3) * 1024); }
        if (PF) __builtin_amdgcn_sched_barrier(0);
#pragma unroll
        for (int n = 0; n < 4; ++n) acc[2 * mp][n] = __builtin_amdgcn_mfma_f32_16x16x32_bf16(bf[n], a0, acc[2 * mp][n], 0, 0, 0);
#pragma unroll
        for (int n = 0; n < 4; ++n) acc[2 * mp + 1][n] = __builtin_amdgcn_mfma_f32_16x16x32_bf16(bf[n], a1, acc[2 * mp + 1][n], 0, 0, 0);
        a0 = n0; a1 = n1;
    }
}
DEV void mma_stage_part(const char* st, int aoff, int boff, int npair, f32x4 (&acc)[8][4]) {
    if (npair <= 0) return;
    bf16x8 bf[4];
#pragma unroll
    for (int n = 0; n < 4; ++n) bf[n] = *(const bf16x8*)(st + ST_A + boff + n * 1024);
#pragma unroll
    for (int mp = 0; mp < 4; ++mp) {
        if (mp < npair) {
            const bf16x8 a0 = *(const bf16x8*)(st + aoff + (2 * mp) * 1024), a1 = *(const bf16x8*)(st + aoff + (2 * mp + 1) * 1024);
#pragma unroll
            for (int n = 0; n < 4; ++n) acc[2 * mp][n] = __builtin_amdgcn_mfma_f32_16x16x32_bf16(bf[n], a0, acc[2 * mp][n], 0, 0, 0);
#pragma unroll
            for (int n = 0; n < 4; ++n) acc[2 * mp + 1][n] = __builtin_amdgcn_mfma_f32_16x16x32_bf16(bf[n], a1, acc[2 * mp + 1][n], 0, 0, 0);
        }
    }
}
DEV void frag_offsets(int& aoff, int& boff) {
    const int lane = TIDX & 63, wid = TIDX >> 6, wr = wid >> 1, wc = wid & 1, fr = lane & 15, fq = lane >> 4;
    const int fo = (((fr >> 2) & 3) ^ swzF(fq)) * 16;
    aoff = (wr * 128 + fr) * 64 + fo; boff = (wc * 64 + fr) * 64 + fo;
}
template <bool PFX = false, class AL, class BL>
DEV void gemm_loop(char* smem, AL& al, BL& bl, int nk, f32x4 (&acc)[8][4], bool rep = false) {
    int aoff, boff; frag_offsets(aoff, boff);
    const bool noMMA = rep && (PROBE_VARIANT == 2), noB = rep && (PROBE_VARIANT == 3 || PROBE_VARIANT == 5 || PROBE_VARIANT >= 7), noA = rep && (PROBE_VARIANT == 4 || PROBE_VARIANT == 5 || PROBE_VARIANT >= 7), noBar = rep && (PROBE_VARIANT == 6 || PROBE_VARIANT == 8 || PROBE_VARIANT == 9);
    char* pc = smem; char* pn = smem + STAGE_B; char* pnn = smem + 2 * STAGE_B;
    if (!noA) al.issue(0, pc); if (!noB) bl.issue(0, pc + ST_A);
    if (!noA) al.issue(1, pn); if (!noB) bl.issue(1, pn + ST_A);
    asm volatile("s_waitcnt vmcnt(0)" ::: "memory");
    __builtin_amdgcn_s_barrier();
#pragma unroll 1
    for (int kt = 0; kt < nk; ++kt) {
        const bool more = (kt + 2 < nk);
        if (more) { if (!noA) al.issue(kt + 2, pnn); if (!noB) bl.issue(kt + 2, pnn + ST_A); }
        if (rep && (PROBE_VARIANT == 7 || PROBE_VARIANT == 9)) {
            bf16x8 fa = {1, 2, 3, 4, 5, 6, 7, 8}; asm volatile("" : "+v"(fa));
#pragma unroll
            for (int m = 0; m < 8; ++m)
#pragma unroll
                for (int n = 0; n < 4; ++n) acc[m][n] = __builtin_amdgcn_mfma_f32_16x16x32_bf16(fa, fa, acc[m][n], 0, 0, 0);
        } else if (!noMMA) mma_stage<PFX>(pc, aoff, boff, acc);
        if (rep && PROBE_VARIANT != 0 && PROBE_VARIANT != 1) { asm volatile("s_waitcnt vmcnt(0)" ::: "memory"); }
        else { if (more) asm volatile("s_waitcnt vmcnt(6)" ::: "memory"); else asm volatile("s_waitcnt vmcnt(0)" ::: "memory"); }
        asm volatile("s_waitcnt lgkmcnt(0)" ::: "memory");
        if (!noBar) __builtin_amdgcn_s_barrier();
        char* t = pc; pc = pn; pn = pnn; pnn = t;
    }
}
template <class AL, class BL>
DEV void gemm_loop_regb(char* smem, AL& al, BL& bl, int nk, int valid, f32x4 (&acc)[8][4], bool rep = false) {
    int aoff, boff; frag_offsets(aoff, boff);
    const int npair = min(4, max(0, (valid - (int)(TIDX >> 7) * 128 + 31) >> 5));
    const bool noMMA = rep && (PROBE_VARIANT == 2), noB = rep && (PROBE_VARIANT == 3), noA = rep && (PROBE_VARIANT == 4);
    char* pc = smem; char* pn = smem + STAGE_B;
    if (!noA) al.issue(0, pc); if (!noB) bl.load(0); bl.store(pc + ST_A);
    asm volatile("s_waitcnt vmcnt(0)" ::: "memory");
    __syncthreads();
#pragma unroll 1
    for (int kt = 0; kt < nk; ++kt) {
        const bool more = (kt + 1 < nk);
        if (more) { if (!noA) al.issue(kt + 1, pn); if (!noB) bl.load(kt + 1); }
        if (!noMMA) { if (npair == 4) mma_stage<false>(pc, aoff, boff, acc); else mma_stage_part(pc, aoff, boff, npair, acc); }
        if (more) bl.store(pn + ST_A);
        asm volatile("s_waitcnt vmcnt(0)" ::: "memory");
        __syncthreads();
        char* t = pc; pc = pn; pn = t;
    }
}
constexpr int XM = 320, XST_A = XM * 64, XSTAGE = XST_A + ST_B;
struct XGather {
    const char* base; unsigned off[5]; unsigned kstb;
    DEV void issue(int kt, char* img) {
        char* d = img + (TIDX >> 6) * 1024;
#pragma unroll
        for (int i = 0; i < 5; ++i) __builtin_amdgcn_global_load_lds((const unsigned*)(base + (size_t)(off[i] + (unsigned)kt * kstb)), (unsigned*)(d + i * 4096), 16, 0, 0);
    }
};
DEV void zero_acc10(f32x4 (&acc)[10][4]) {
#pragma unroll
    for (int m = 0; m < 10; ++m)
#pragma unroll
        for (int n = 0; n < 4; ++n) acc[m][n] = (f32x4){0.f, 0.f, 0.f, 0.f};
}
DEV void mma_stage10(const char* st, int aoff, int boff, int npair, f32x4 (&acc)[10][4]) {
    if (npair <= 0) return;
    bf16x8 bf[4];
#pragma unroll
    for (int n = 0; n < 4; ++n) bf[n] = *(const bf16x8*)(st + XST_A + boff + n * 1024);
#pragma unroll
    for (int mp = 0; mp < 5; ++mp) {
        if (mp < npair) {
            const bf16x8 a0 = *(const bf16x8*)(st + aoff + (2 * mp) * 1024), a1 = *(const bf16x8*)(st + aoff + (2 * mp + 1) * 1024);
#pragma unroll
            for (int n = 0; n < 4; ++n) acc[2 * mp][n] = __builtin_amdgcn_mfma_f32_16x16x32_bf16(bf[n], a0, acc[2 * mp][n], 0, 0, 0);
#pragma unroll
            for (int n = 0; n < 4; ++n) acc[2 * mp + 1][n] = __builtin_amdgcn_mfma_f32_16x16x32_bf16(bf[n], a1, acc[2 * mp + 1][n], 0, 0, 0);
        }
    }
}
template <class AL, class BL>
DEV void gemm_loop_x(char* smem, AL& al, BL& bl, int nk, int valid, f32x4 (&acc)[10][4]) {
    const int lane = TIDX & 63, wid = TIDX >> 6, wr = wid >> 1, wc = wid & 1, fr = lane & 15, fq = lane >> 4;
    const int fo = (((fr >> 2) & 3) ^ swzF(fq)) * 16;
    const int aoff = (wr * 160 + fr) * 64 + fo, boff = (wc * 64 + fr) * 64 + fo;
    const int npair = min(5, max(0, (valid - wr * 160 + 31) >> 5));
    char* pc = smem; char* pn = smem + XSTAGE;
    al.issue(0, pc); bl.load(0); bl.store(pc + XST_A);
    asm volatile("s_waitcnt vmcnt(0)" ::: "memory");
    __syncthreads();
#pragma unroll 1
    for (int kt = 0; kt < nk; ++kt) {
        const bool more = (kt + 1 < nk);
        if (more) { al.issue(kt + 1, pn); bl.load(kt + 1); }
        mma_stage10(pc, aoff, boff, npair, acc);
        if (more) bl.store(pn + XST_A);
        asm volatile("s_waitcnt vmcnt(0)" ::: "memory");
        __syncthreads();
        char* t = pc; pc = pn; pn = t;
    }
}
struct Row16 {
    f32x4 a0, a1, a2, a3;
    DEV float get(int q) const { return (q < 4) ? a0[q & 3] : (q < 8) ? a1[q & 3] : (q < 12) ? a2[q & 3] : a3[q & 3]; }
};
template <class F> DEV void epi_rows(const f32x4 (&acc)[8][4], F fn) {
    const int lane = TIDX & 63, wid = TIDX >> 6, wr = wid >> 1, wc = wid & 1, fr = lane & 15, fq = lane >> 4;
#pragma unroll
    for (int m = 0; m < 8; ++m) {
        Row16 v; v.a0 = acc[m][0]; v.a1 = acc[m][1]; v.a2 = acc[m][2]; v.a3 = acc[m][3];
        fn(wr * 128 + m * 16 + fr, wc * 64 + fq * 16, v);
        __builtin_amdgcn_sched_barrier(0);
    }
}
template <class F> DEV void epi_rows10(const f32x4 (&acc)[10][4], F fn) {
    const int lane = TIDX & 63, wid = TIDX >> 6, wr = wid >> 1, wc = wid & 1, fr = lane & 15, fq = lane >> 4;
#pragma unroll
    for (int m = 0; m < 10; ++m) {
        Row16 v; v.a0 = acc[m][0]; v.a1 = acc[m][1]; v.a2 = acc[m][2]; v.a3 = acc[m][3];
        fn(wr * 160 + m * 16 + fr, wc * 64 + fq * 16, v);
        __builtin_amdgcn_sched_barrier(0);
    }
}
DEV void st16_bf16(bf16_t* d, const Row16& v) {
    u32x4 a, b;
    a.x = pack2(v.a0[0], v.a0[1]); a.y = pack2(v.a0[2], v.a0[3]); a.z = pack2(v.a1[0], v.a1[1]); a.w = pack2(v.a1[2], v.a1[3]);
    b.x = pack2(v.a2[0], v.a2[1]); b.y = pack2(v.a2[2], v.a2[3]); b.z = pack2(v.a3[0], v.a3[1]); b.w = pack2(v.a3[2], v.a3[3]);
    *(u32x4*)d = a; *(u32x4*)(d + 8) = b;
}
DEV void st16_f32(float* d, const Row16& v) { *(f32x4*)d = v.a0; *(f32x4*)(d + 4) = v.a1; *(f32x4*)(d + 8) = v.a2; *(f32x4*)(d + 12) = v.a3; }
DEV void st16_bf16(bf16_t* d, const float* v) {
    u32x4 a, b;
    a.x = pack2(v[0], v[1]); a.y = pack2(v[2], v[3]); a.z = pack2(v[4], v[5]); a.w = pack2(v[6], v[7]);
    b.x = pack2(v[8], v[9]); b.y = pack2(v[10], v[11]); b.z = pack2(v[12], v[13]); b.w = pack2(v[14], v[15]);
    *(u32x4*)d = a; *(u32x4*)(d + 8) = b;
}
DEV void st8_bf16(bf16_t* d, const float* v) {
    u32x4 a; a.x = pack2(v[0], v[1]); a.y = pack2(v[2], v[3]); a.z = pack2(v[4], v[5]); a.w = pack2(v[6], v[7]);
    *(u32x4*)d = a;
}
DEV void st16_f32(float* d, const float* v) {
#pragma unroll
    for (int q = 0; q < 4; ++q) *(f32x4*)(d + 4 * q) = (f32x4){v[4 * q], v[4 * q + 1], v[4 * q + 2], v[4 * q + 3]};
}
DEV void ld16_f32(const float* s, float* v) {
#pragma unroll
    for (int q = 0; q < 4; ++q) { const f32x4 t = *(const f32x4*)(s + 4 * q); v[4 * q] = t[0]; v[4 * q + 1] = t[1]; v[4 * q + 2] = t[2]; v[4 * q + 3] = t[3]; }
}
DEV void ld16_bf16(const bf16_t* s, float* v) {
    const bf16x8 a = *(const bf16x8*)s, b = *(const bf16x8*)(s + 8);
#pragma unroll
    for (int q = 0; q < 8; ++q) { v[q] = bf2f((bf16_t)a[q]); v[8 + q] = bf2f((bf16_t)b[q]); }
}
DEV float sum_fq(float s) { s += __shfl_xor(s, 16); s += __shfl_xor(s, 32); return s; }

DEV void up_row_map(int nt, int R, int& mat, int& j) { const int wc = R >> 6, n = (R >> 4) & 3, fq = (R >> 2) & 3, reg = R & 3; mat = n >> 1; j = nt * 64 + wc * 32 + fq * 8 + (n & 1) * 4 + reg; }
DEV int win_src_col(int nd) { if (nd < 3072) return nd; if (nd < 3584) return nd + 16; if (nd < 3600) return nd - 512; return -1; }

template <class F> DEV void transpose_tile(char* smem, F srcfn, bf16_t* dst, int ldd, int k0, int nd0, bool pk = false) {
    float* t = (float*)smem;
    const int tid = TIDX, a = tid & 63, q = tid >> 6;
#pragma unroll 4
    for (int i = 0; i < 16; ++i) { const int k = q + 4 * i; t[k * 65 + a] = srcfn(k0 + k, nd0 + a); }
    __syncthreads();
#pragma unroll 4
    for (int i = 0; i < 16; ++i) { const int nl = q + 4 * i; const long o = pk ? pkl(nd0 + nl, k0 + a, ldd >> 5) : (long)(nd0 + nl) * ldd + k0 + a; dst[o] = f2bf(t[a * 65 + nl]); }
    __syncthreads();
}
DEV void s5_disc(CParams& p, int g, int n, float& lr, float& rev, float& f_re, float& f_im) {
    const float dt = __expf(p.s5_log_dt[g]);
    const float lre = fminf(p.s5_a_re[g * 64 + n], -1e-4f), lim = p.s5_a_im[g * 64 + n];
    lr = lre * dt; rev = lim * dt * 0.15915494309189535f;
    const float mag = __expf(lr), fr_ = __builtin_amdgcn_fractf(rev);
    const float ab_re = mag * __builtin_amdgcn_cosf(fr_), ab_im = mag * __builtin_amdgcn_sinf(fr_);
    const float den = lre * lre + lim * lim, num_re = ab_re - 1.f;
    f_re = (num_re * lre + ab_im * lim) / den; f_im = (ab_im * lre - num_re * lim) / den;
}
DEV void cpow(float lr, float rev, float tau, float& re, float& im) {
    const float mag = __expf(lr * tau), fr_ = __builtin_amdgcn_fractf(rev * tau);
    re = mag * __builtin_amdgcn_cosf(fr_); im = mag * __builtin_amdgcn_sinf(fr_);
}

constexpr int P0_MOD = 192, P0_WIN = 16 * 58, P0_WOUT = 24 * 16, P0_WGLU = 64, P0_WR = 64, P0_WSUP = 128, P0_WS2 = 64, P0_KERN = 1024, P0_W5S = 1024, P0_E5 = 1024, P0_ZERO = 16;
constexpr int P0_TASKS = P0_MOD + P0_WIN + P0_WOUT + P0_WGLU + P0_WR + P0_WSUP + P0_WS2 + P0_KERN + P0_W5S + P0_E5 + P0_ZERO;

DEV void phase0(CParams& p, int task, char* smem, unsigned* modcnt) {
    const int tid = TIDX;
    if (task < P0_MOD) {
        const int c4 = tid & 7, kq = tid >> 3, n0 = task * 32 + c4 * 4;
        f32x4 a0 = {0.f, 0.f, 0.f, 0.f}, a1 = {0.f, 0.f, 0.f, 0.f};
        for (int k0 = kq; k0 < 1024; k0 += 256) {
            f32x4 w[8]; float c0[8], c1[8];
#pragma unroll
            for (int u = 0; u < 8; ++u) { const int k = k0 + 32 * u; w[u] = *(const f32x4*)(p.w_ada + (long)k * 6144 + n0); c0[u] = p.c[k]; c1[u] = p.c[1024 + k]; }
#pragma unroll
            for (int u = 0; u < 8; ++u) { a0 += siluf_(c0[u]) * w[u]; a1 += siluf_(c1[u]) * w[u]; }
        }
        float* red = (float*)smem;
        *(f32x4*)(red + (kq * 8 + c4) * 8) = a0; *(f32x4*)(red + (kq * 8 + c4) * 8 + 4) = a1;
        __syncthreads();
        if (tid < 64) {
            const int b = tid >> 5, col = tid & 31, c4o = col >> 2, e = col & 3;
            float s = 0.f;
            for (int q = 0; q < 32; ++q) s += red[(q * 8 + c4o) * 8 + b * 4 + e];
            p.MOD[b * 6144 + task * 32 + col] = s + p.b_ada[task * 32 + col];
        }
        asm volatile("s_waitcnt vmcnt(0)" ::: "memory");
        __syncthreads();
        if (tid == 0) {
            __builtin_amdgcn_fence(__ATOMIC_RELEASE, "agent");
            asm volatile("s_waitcnt vmcnt(0)" ::: "memory");
            __hip_atomic_fetch_add(modcnt, 1u, __ATOMIC_RELAXED, __HIP_MEMORY_SCOPE_AGENT);
        }
        return;
    }
    task -= P0_MOD;
    if (task < P0_WIN) {
        const int kt = task / 58, nt = task % 58;
        transpose_tile(smem, [&](int k, int nd) __attribute__((always_inline)) { const int sc = win_src_col(nd); return sc < 0 ? 0.f : p.w_in[(long)k * NPROJ + sc]; }, p.WINT, 1024, kt * 64, nt * 64, true);
        return;
    }
    task -= P0_WIN;
    if (task < P0_WOUT) {
        const int kt = task / 16, nt = task % 16;
        transpose_tile(smem, [&](int k, int nd) __attribute__((always_inline)) { const float g = (k < 1024) ? p.ssd_norm_gain[k] : p.s5_norm_gain[k - 1024]; return g * p.w_out[(long)k * 1024 + nd]; }, p.WOUTT, 1536, kt * 64, nt * 64, true);
        return;
    }
    task -= P0_WOUT;
    if (task < P0_WGLU) {
        const int kt = task / 8, nt = task % 8;
        transpose_tile(smem, [&](int k, int nd) __attribute__((always_inline)) { return p.w_glu[(long)k * 512 + nd]; }, p.WGLUT, 512, kt * 64, nt * 64, true);
        return;
    }
    task -= P0_WGLU;
    if (task < P0_WR) {
        const int kt = task / 4, nt = task % 4;
        transpose_tile(smem, [&](int k, int nd) __attribute__((always_inline)) { return p.w_router[(long)k * 256 + nd]; }, p.WRT, 1024, kt * 64, nt * 64, true);
        return;
    }
    task -= P0_WR;
    if (task < P0_WSUP) {
        const int kt = task / 8, nt = task % 8;
        transpose_tile(smem, [&](int k, int nd) __attribute__((always_inline)) { int mat, j; up_row_map(nd >> 7, nd & 127, mat, j); return (mat ? p.ws3 : p.ws1)[(long)k * 256 + j]; }, p.WSUPT, 1024, kt * 64, nt * 64, true);
        return;
    }
    task -= P0_WSUP;
    if (task < P0_WS2) {
        const int kt = task / 16, nt = task % 16;
        transpose_tile(smem, [&](int k, int nd) __attribute__((always_inline)) { return p.ws2[(long)k * 1024 + nd]; }, p.WS2T, 256, kt * 64, nt * 64, true);
        return;
    }
    task -= P0_WS2;
    float* sG = (float*)smem;
    if (task < P0_KERN) {
        const int g = task >> 5, tau = task & 31;
        if (tid < 64) {
            float lr, rev, fre, fim, pr, pi; s5_disc(p, g, tid, lr, rev, fre, fim); cpow(lr, rev, (float)tau, pr, pi);
            sG[tid * 2] = pr * fre - pi * fim; sG[tid * 2 + 1] = pr * fim + pi * fre;
        }
        __syncthreads();
        const int pp = tid >> 4, q = tid & 15;
        float s = 0.f;
        for (int n = 0; n < 64; ++n) {
            const float cr = p.s5_c_re[(g * 16 + pp) * 64 + n], ci = p.s5_c_im[(g * 16 + pp) * 64 + n];
            const float gr = sG[n * 2], gi = sG[n * 2 + 1];
            const float xr = cr * gr - ci * gi, xi = cr * gi + ci * gr;
            const float br = p.s5_b_re[(g * 64 + n) * 16 + q], bi = p.s5_b_im[(g * 64 + n) * 16 + q];
            s += xr * br - xi * bi;
        }
        p.KERN[(long)(g * 32 + tau) * 256 + tid] = s;
        __syncthreads();
        return;
    }
    task -= P0_KERN;
    if (task < P0_W5S) {
        const int g = task >> 5, tp = task & 31;
        if (tid < 64) { float lr, rev, fre, fim, pr, pi; s5_disc(p, g, tid, lr, rev, fre, fim); cpow(lr, rev, (float)(tp + 1), pr, pi); sG[tid * 2] = pr; sG[tid * 2 + 1] = pi; }
        __syncthreads();
#pragma unroll
        for (int i = 0; i < 8; ++i) {
            const int idx = tid + 256 * i, pp = idx >> 7, m = idx & 127, n = m & 63;
            const float cr = p.s5_c_re[(g * 16 + pp) * 64 + n], ci = p.s5_c_im[(g * 16 + pp) * 64 + n];
            const float gr = sG[n * 2], gi = sG[n * 2 + 1];
            const float v = (m < 64) ? (cr * gr - ci * gi) : -(cr * gi + ci * gr);
            p.W5T[(long)g * 512 * 640 + pkl(tp * 16 + pp, 512 + m, 20)] = f2bf(v);
        }
        __syncthreads();
        return;
    }
    task -= P0_W5S;
    if (task < P0_E5) {
        const int g = task >> 5, jp = task & 31;
        if (tid < 64) {
            float lr, rev, fre, fim, pr, pi; s5_disc(p, g, tid, lr, rev, fre, fim); cpow(lr, rev, (float)(S5Q - 1 - jp), pr, pi);
            sG[tid * 2] = pr * fre - pi * fim; sG[tid * 2 + 1] = pr * fim + pi * fre;
            if (jp == 0) { float qr, qi; cpow(lr, rev, (float)S5Q, qr, qi); p.AQ[(g * 64 + tid) * 2] = qr; p.AQ[(g * 64 + tid) * 2 + 1] = qi; }
        }
        __syncthreads();
#pragma unroll
        for (int i = 0; i < 8; ++i) {
            const int idx = tid + 256 * i, m = idx >> 4, q = idx & 15, n = m & 63;
            const float gr = sG[n * 2], gi = sG[n * 2 + 1];
            const float br = p.s5_b_re[(g * 64 + n) * 16 + q], bi = p.s5_b_im[(g * 64 + n) * 16 + q];
            const float v = (m < 64) ? (gr * br - gi * bi) : (gr * bi + gi * br);
            p.E5T[(long)g * 128 * 512 + pkl(m, jp * 16 + q, 16)] = f2bf(v);
        }
        __syncthreads();
        return;
    }
    task -= P0_E5;
    {
        if (task == 0) p.CNT[tid] = 0;
    }
}

DEV void modnorm_row(const float* src, int row, const float* gain, const float* sc, const float* sh, const float* ssq, bf16_t* dst) {
    const int lane = TIDX & 63;
    const float* xr = src + (long)row * 1024;
    f32x4 v[4];
#pragma unroll
    for (int i = 0; i < 4; ++i) v[i] = *(const f32x4*)(xr + lane * 4 + 256 * i);
    float ss;
    if (ssq) { ss = 0.f;
#pragma unroll
        for (int q = 0; q < 16; ++q) ss += ssq[(long)row * 16 + q]; }
    else {
        ss = 0.f;
#pragma unroll
        for (int i = 0; i < 4; ++i) ss += v[i][0] * v[i][0] + v[i][1] * v[i][1] + v[i][2] * v[i][2] + v[i][3] * v[i][3];
        ss = wave_sum(ss);
    }
    const float rstd = rsqrtf(ss * (1.f / 1024.f) + 1e-6f);
#pragma unroll
    for (int i = 0; i < 4; ++i) {
        const int c = lane * 4 + 256 * i;
        const f32x4 g = *(const f32x4*)(gain + c), s1 = *(const f32x4*)(sc + c), s0 = *(const f32x4*)(sh + c);
        float o[4];
#pragma unroll
        for (int e = 0; e < 4; ++e) o[e] = v[i][e] * rstd * g[e] * (1.f + s1[e]) + s0[e];
        u32x2 w; w.x = pack2(o[0], o[1]); w.y = pack2(o[2], o[3]);
        *(u32x2*)(dst + pkl(row, c, 32)) = w;
    }
}
constexpr int P0B_ROWS = T_TOK / 4, P0B_TOEP = 1024;
DEV void phase0b_rows(CParams& p, int task) {
    const int row = task * 4 + (TIDX >> 6), b = row >> 13;
    modnorm_row(p.x, row, p.norm1_gain, p.MOD + b * 6144 + 1024, p.MOD + b * 6144, nullptr, p.H);
}
DEV void phase0b_toep(CParams& p, int task) {
    const int g = task >> 5, tp = task & 31;
#pragma unroll
    for (int i = 0; i < 4; ++i) {
        const int idx = TIDX + 256 * i, pp = idx >> 6, kc8 = (idx & 63) * 8, jp = kc8 >> 4, q0 = kc8 & 15;
        float v[8];
        if (jp <= tp) {
            const float* s = p.KERN + (long)(g * 32 + (tp - jp)) * 256 + pp * 16 + q0;
            const f32x4 a = *(const f32x4*)s, b4 = *(const f32x4*)(s + 4);
#pragma unroll
            for (int q = 0; q < 4; ++q) { v[q] = a[q]; v[4 + q] = b4[q]; }
        } else {
#pragma unroll
            for (int q = 0; q < 8; ++q) v[q] = 0.f;
        }
        st8_bf16(p.W5T + (long)g * 512 * 640 + pkl(tp * 16 + pp, kc8, 20), v);
    }
}

DEV bool xcd_tile(int idx, int MT, int NT, int& mt, int& nt) {
    const int x = blockIdx.x & 7, member = blockIdx.x >> 3, nmem = (gridDim.x - x + 7) >> 3;
    const int per = MT >> 3, j = member + idx * nmem;
    if (j >= per * NT) return false;
    mt = x * per + j % per; nt = j / per; return true;
}

constexpr int Q_SLOTS = 8, Q_WORDS = Q_SLOTS * 2 * 8 * 16;
DEV unsigned* q_head(CParams& p, int slot, bool rep, int group) { return p.bar + XCD_BAR_WORDS + ((slot * 2 + (rep ? 1 : 0)) * 8 + group) * 16; }
DEV int dq_next(unsigned* q, char* smem) {
    volatile LAS unsigned* w = (volatile LAS unsigned*)(smem + SMEM_BYTES - 32);
    __syncthreads();
    if (TIDX == 0) *w = __hip_atomic_fetch_add(q, 1u, __ATOMIC_RELAXED, __HIP_MEMORY_SCOPE_AGENT);
    __syncthreads();
    return (int)*w;
}

constexpr int P1_TASKS = 64 * 29;
DEV void phase1(CParams& p, int mt, int nt, char* smem, bool rep = false) {
    GRow<4> al; al.initp(p.H, 32, (long)mt * 256, false);
    GRow<2> bl; bl.initp(p.WINT, 32, (long)nt * 128, true);
    f32x4 acc[8][4]; zero_acc(acc);
    gemm_loop<true>(smem, al, bl, 32, acc, rep);
    epi_rows(acc, [&](int r, int c0, const Row16& v) __attribute__((always_inline)) {
        const long t = (long)mt * 256 + r;
        if (rep) { st16_bf16(p.OUTR + t * 4096 + nt * 128 + c0, v); return; }
        if (nt < 8) st16_bf16(p.Z + t * 1024 + nt * 128 + c0, v);
        else if (nt < 24) st16_bf16(p.XBCR + t * 2048 + (nt - 8) * 128 + c0, v);
        else if (nt < 28) { const int g = ((nt - 24) * 128 + c0) >> 4; st16_bf16(p.UG + (long)g * T_TOK * 16 + pkl(t >> 5, (int)(t & 31) * 16, 16), v); }
        else if (c0 == 0) st16_f32(p.DTR + t * 16, v);
    });
}

constexpr int P2_CONV = 2048, P2_E = 64, P2_TASKS = P2_CONV + P2_E;
DEV void phase2(CParams& p, int task, char* smem) {
    const int tid = TIDX;
    if (task < P2_CONV) {
        const int b = task >> 10, c = (task >> 5) & 31, cb = task & 31;
        float* sT = (float*)smem;
        float* sdt = sT + 64 * 257;
        float* sdec = sdt + 256;
        float* sscan = sdec + 256;
        const bool isx = cb < 16;
        if (isx) {
            const int h = cb;
            const float raw = p.DTR[((long)b * SEQ + c * 256 + tid) * 16 + h] + p.dt_bias[h];
            const float dtv = raw > 20.f ? raw : log1pf(__expf(raw));
            const float a = -__expf(p.ssd_a_log[h]);
            sscan[tid] = dtv * a;
            __syncthreads();
            for (int off = 1; off < 256; off <<= 1) {
                const float v = (tid >= off) ? sscan[tid - off] : 0.f;
                __syncthreads();
                sscan[tid] += v;
                __syncthreads();
            }
            const float acs = sscan[tid], aend = sscan[255];
            p.ACS[((long)b * 16 + h) * SEQ + c * 256 + tid] = acs;
            sdt[tid] = dtv; sdec[tid] = dtv * __expf(aend - acs);
        }
        __syncthreads();
        {
            const int cg = tid & 7, tg = tid >> 3, gch0 = cb * 64 + cg * 8, t0 = c * 256 + tg * 8;
            float w[4][8], bias[8];
#pragma unroll
            for (int k = 0; k < 4; ++k) { const f32x4 a = *(const f32x4*)(p.conv_w + k * 2048 + gch0), b4 = *(const f32x4*)(p.conv_w + k * 2048 + gch0 + 4);
#pragma unroll
                for (int q = 0; q < 4; ++q) { w[k][q] = a[q]; w[k][4 + q] = b4[q]; } }
            { const f32x4 a = *(const f32x4*)(p.conv_b + gch0), b4 = *(const f32x4*)(p.conv_b + gch0 + 4);
#pragma unroll
              for (int q = 0; q < 4; ++q) { bias[q] = a[q]; bias[4 + q] = b4[q]; } }
            const bf16_t* rawp = p.XBCR + (long)b * SEQ * 2048 + gch0;
            bf16x8 rows[11];
#pragma unroll
            for (int i = 0; i < 11; ++i) { const int t = t0 - 3 + i; rows[i] = (t >= 0) ? *(const bf16x8*)(rawp + (long)t * 2048) : (bf16x8){0, 0, 0, 0, 0, 0, 0, 0}; }
            float v[8][8];
#pragma unroll
            for (int i = 0; i < 8; ++i)
#pragma unroll
                for (int q = 0; q < 8; ++q) {
                    float s = bias[q];
#pragma unroll
                    for (int k = 0; k < 4; ++k) s += w[k][q] * bf2f((bf16_t)rows[i + k][q]);
                    v[i][q] = siluf_(s);
                }
            bf16_t* natp; long nld;
            if (cb < 16) { natp = p.XN + gch0; nld = 1024; } else if (cb < 24) { natp = p.BN + (gch0 - 1024); nld = 512; } else { natp = p.CN + (gch0 - 1536); nld = 512; }
#pragma unroll
            for (int i = 0; i < 8; ++i) st8_bf16(natp + ((long)b * SEQ + t0 + i) * nld, v[i]);
            if (isx) {
                float dtv[8], dcv[8];
#pragma unroll
                for (int i = 0; i < 8; ++i) { dtv[i] = sdt[tg * 8 + i]; dcv[i] = sdec[tg * 8 + i]; }
#pragma unroll
                for (int q = 0; q < 8; ++q) {
                    float a[8], d[8];
#pragma unroll
                    for (int i = 0; i < 8; ++i) { a[i] = v[i][q] * dtv[i]; d[i] = v[i][q] * dcv[i]; }
                    const long o = (((long)b * 16 + cb) * 64 + cg * 8 + q) * SEQ + t0;
                    st8_bf16(p.XDTT + o, a); st8_bf16(p.XDECT + pkl(((long)b * 16 + cb) * 64 + cg * 8 + q, t0, 256), d);
                }
            } else if (cb < 24) {
                const int g = (cb - 16) >> 1, half = (cb - 16) & 1;
#pragma unroll
                for (int q = 0; q < 8; ++q) {
                    float a[8];
#pragma unroll
                    for (int i = 0; i < 8; ++i) a[i] = v[i][q];
                    st8_bf16(p.BT + pkl(((long)b * 4 + g) * 128 + half * 64 + cg * 8 + q, t0, 256), a);
                }
            }
        }
        __syncthreads();
        return;
    }
}
DEV void phase2e5(CParams& p, int task, char* smem) {
    {
        const int g = task >> 1, mt = task & 1;
        GRow<4> al; al.initp(p.UG + (long)g * T_TOK * 16, 16, (long)mt * 256, false);
        GRow<2> bl; bl.initp(p.E5T + (long)g * 128 * 512, 16, 0, true);
        f32x4 acc[8][4]; zero_acc(acc);
        gemm_loop<true>(smem, al, bl, 16, acc);
        epi_rows(acc, [&](int r, int c0, const Row16& v) __attribute__((always_inline)) { st16_f32(p.E5 + ((long)g * 512 + mt * 256 + r) * 128 + c0, v); });
    }
}

constexpr int P3_ST = 256, P3_CARRY = 256, P3_TASKS = P3_ST + P3_CARRY;
DEV void phase3(CParams& p, int task, char* smem) {
    const int tid = TIDX;
    if (task < P3_ST) {
        const int g = task & 3, c = (task >> 2) & 31, b = task >> 7;
        GRow<4> al; al.initp(p.XDECT, 256, ((long)b * 16 + 4 * g) * 64, false, c * 8);
        GRow<2> bl; bl.initp(p.BT, 256, ((long)b * 4 + g) * 128, true, c * 8);
        f32x4 acc[8][4]; zero_acc(acc);
        gemm_loop<true>(smem, al, bl, 8, acc);
        float* dst = p.ST + ((((long)b * 32 + c) * 16 + 4 * g) * 64) * 128;
        epi_rows(acc, [&](int r, int c0, const Row16& v) __attribute__((always_inline)) { st16_f32(dst + (long)r * 128 + c0, v); });
        return;
    }
    task -= P3_ST;
    {
        const int nq = task & 3, g = (task >> 2) & 31, b = task >> 7;
        const int n = nq * 16 + (tid & 15), seg = tid >> 4;
        const float qr = p.AQ[(g * 64 + n) * 2], qi = p.AQ[(g * 64 + n) * 2 + 1];
        const float* e = p.E5 + ((long)g * 512 + b * 256 + seg * 16) * 128;
        float er[16], ei[16];
#pragma unroll
        for (int u = 0; u < 16; ++u) { er[u] = e[(long)u * 128 + n]; ei[u] = e[(long)u * 128 + 64 + n]; }
        float tr = 0.f, ti = 0.f;
#pragma unroll
        for (int u = 0; u < 16; ++u) {
            const float lr = tr, li = ti;
            const float nr = qr * tr - qi * ti + er[u], ni = qr * ti + qi * tr + ei[u];
            tr = nr; ti = ni; er[u] = lr; ei[u] = li;
        }
        float pr = qr, pi = qi;
#pragma unroll
        for (int s = 0; s < 4; ++s) { const float a = pr * pr - pi * pi, c2 = 2.f * pr * pi; pr = a; pi = c2; }
        float* sx = (float*)smem;
        sx[(seg * 16 + (tid & 15)) * 2] = tr; sx[(seg * 16 + (tid & 15)) * 2 + 1] = ti;
        __syncthreads();
        if (tid < 16) {
            float sr = 0.f, si = 0.f;
            for (int s = 0; s < 16; ++s) {
                const float t0 = sx[(s * 16 + tid) * 2], t1 = sx[(s * 16 + tid) * 2 + 1];
                sx[(s * 16 + tid) * 2] = sr; sx[(s * 16 + tid) * 2 + 1] = si;
                const float nr = pr * sr - pi * si + t0, ni = pr * si + pi * sr + t1;
                sr = nr; si = ni;
            }
        }
        __syncthreads();
        float sr = sx[(seg * 16 + (tid & 15)) * 2], si = sx[(seg * 16 + (tid & 15)) * 2 + 1];
        bf16_t* o = p.SPREV + (long)g * 512 * 128;
#pragma unroll
        for (int u = 0; u < 16; ++u) {
            const int row = b * 256 + seg * 16 + u;
            o[pkl(row, n, 4)] = f2bf(sr + er[u]); o[pkl(row, 64 + n, 4)] = f2bf(si + ei[u]);
            const float nr = qr * sr - qi * si, ni = qr * si + qi * sr;
            sr = nr; si = ni;
        }
        __syncthreads();
    }
}

constexpr int P4_SCAN = 256, P4_Y = 256, P4_TASKS = P4_SCAN + P4_Y;
DEV void phase4(CParams& p, int task, char* smem) {
    const int tid = TIDX;
    if (task < P4_SCAN) {
        const int id = task * 256 + tid, pn = (id & 2047) * 4, h = (id >> 11) & 15, b = id >> 15;
        f32x4 s = {0.f, 0.f, 0.f, 0.f};
        for (int c0 = 0; c0 < 32; c0 += 8) {
            f32x4 st[8]; float at[8];
#pragma unroll
            for (int u = 0; u < 8; ++u) {
                st[u] = *(const f32x4*)(p.ST + ((((long)b * 32 + c0 + u) * 16 + h) * 8192) + pn);
                at[u] = p.ACS[((long)b * 16 + h) * SEQ + (c0 + u) * 256 + 255];
            }
#pragma unroll
            for (int u = 0; u < 8; ++u) {
                u32x2 w; w.x = pack2(s[0], s[1]); w.y = pack2(s[2], s[3]);
                *(u32x2*)(p.PREV + ((((long)b * 32 + c0 + u) * 16 + h) * 8192) + pn) = w;
                s = __expf(at[u]) * s + st[u];
            }
        }
        return;
    }
    task -= P4_SCAN;
    {
        const int nt = task & 3, mt = (task >> 2) & 1, g = task >> 3;
        f32x4 acc[8][4]; zero_acc(acc);
        {
            GRow<4> al; al.initp(p.UG + (long)g * T_TOK * 16, 16, (long)mt * 256, false);
            GRow<2> bl; bl.initp(p.W5T + (long)g * 512 * 640, 20, (long)nt * 128, true);
            gemm_loop<true>(smem, al, bl, 4 * (nt + 1), acc);
        }
        {
            GRow<4> al; al.initp(p.SPREV + (long)g * 512 * 128, 4, (long)mt * 256, false);
            GRow<2> bl; bl.initp(p.W5T + (long)g * 512 * 640, 20, (long)nt * 128, true, 16);
            gemm_loop<true>(smem, al, bl, 4, acc);
        }
        epi_rows(acc, [&](int r, int c0, const Row16& v) __attribute__((always_inline)) {
            const int rr = mt * 256 + r, tp = (nt * 128 + c0) >> 4;
            const long t = (long)rr * 32 + tp;
            float u[16], d[16], o[16];
            ld16_bf16(p.UG + (long)g * T_TOK * 16 + pkl(t >> 5, (int)(t & 31) * 16, 16), u);
            ld16_f32(p.s5_d + g * 16, d);
#pragma unroll
            for (int q = 0; q < 16; ++q) o[q] = gelu_tanh(v.get(q) + d[q] * u[q]);
            st16_bf16(p.G5 + pkl(t, g * 16, 16), o);
        });
    }
}

constexpr int P5_SSD = 2048;
DEV void phase5(CParams& p, int task, char* smem) {
    const int tid = TIDX, lane = tid & 63, wid = tid >> 6, fr = lane & 15, fq = lane >> 4;
    if (task < P5_SSD) {
        const int half = task & 1, h = (task >> 1) & 15, c = (task >> 5) & 31, b = task >> 10, g = h >> 2;
        const int l0 = half * 128 + wid * 32;
        const long tok0 = (long)b * SEQ + c * 256;
        char* sB = smem;
        char* sX = smem + 17408;
        char* sM = smem + 17408 + 9216 + wid * 4608;
        float* sacs = (float*)(smem + 17408 + 9216 + 18432);
        sacs[tid] = p.ACS[((long)b * 16 + h) * SEQ + c * 256 + tid];
        bf16x8 cf[2][4];
#pragma unroll
        for (int mi = 0; mi < 2; ++mi)
#pragma unroll
            for (int ks = 0; ks < 4; ++ks) cf[mi][ks] = *(const bf16x8*)(p.CN + (tok0 + l0 + mi * 16 + fr) * 512 + g * 128 + ks * 32 + fq * 8);
        {
            const bf16_t* pv = p.PREV + ((((long)b * 32 + c) * 16 + h) * 64) * 128;
#pragma unroll
            for (int i = 0; i < 4; ++i) { const int q = tid + 256 * i, r = q >> 4, kc = q & 15; *(bf16x8*)(sB + r * 272 + kc * 16) = *(const bf16x8*)(pv + r * 128 + kc * 8); }
        }
        __syncthreads();
        f32x4 y[2][4];
#pragma unroll
        for (int mi = 0; mi < 2; ++mi)
#pragma unroll
            for (int np = 0; np < 4; ++np) y[mi][np] = (f32x4){0.f, 0.f, 0.f, 0.f};
#pragma unroll
        for (int ks = 0; ks < 4; ++ks)
#pragma unroll
            for (int np = 0; np < 4; ++np) {
                const bf16x8 pf = *(const bf16x8*)(sB + (np * 16 + fr) * 272 + ks * 64 + fq * 16);
#pragma unroll
                for (int mi = 0; mi < 2; ++mi) y[mi][np] = __builtin_amdgcn_mfma_f32_16x16x32_bf16(pf, cf[mi][ks], y[mi][np], 0, 0, 0);
            }
        float al[2];
#pragma unroll
        for (int mi = 0; mi < 2; ++mi) {
            al[mi] = sacs[l0 + mi * 16 + fr];
            const float e = __expf(al[mi]);
#pragma unroll
            for (int np = 0; np < 4; ++np) y[mi][np] *= e;
        }
        __syncthreads();
        const int nj = half * 2 + 2;
        bf16x8 rbB[4], rbX[2];
#pragma unroll
        for (int i = 0; i < 4; ++i) { const int q = tid + 256 * i, r = q >> 4, kc = q & 15; rbB[i] = *(const bf16x8*)(p.BN + (tok0 + r) * 512 + g * 128 + kc * 8); }
#pragma unroll
        for (int i = 0; i < 2; ++i) { const int q = tid + 256 * i, r = q >> 3, kc = q & 7; rbX[i] = *(const bf16x8*)(p.XDTT + (((long)b * 16 + h) * 64 + r) * SEQ + c * 256 + kc * 8); }
        for (int jb = 0; jb < nj; ++jb) {
#pragma unroll
            for (int i = 0; i < 4; ++i) { const int q = tid + 256 * i, r = q >> 4, kc = q & 15; *(bf16x8*)(sB + r * 272 + kc * 16) = rbB[i]; }
#pragma unroll
            for (int i = 0; i < 2; ++i) { const int q = tid + 256 * i, r = q >> 3, kc = q & 7; *(bf16x8*)(sX + r * 144 + kc * 16) = rbX[i]; }
            __syncthreads();
            if (jb + 1 < nj) {
#pragma unroll
                for (int i = 0; i < 4; ++i) { const int q = tid + 256 * i, r = q >> 4, kc = q & 15; rbB[i] = *(const bf16x8*)(p.BN + (tok0 + (jb + 1) * 64 + r) * 512 + g * 128 + kc * 8); }
#pragma unroll
                for (int i = 0; i < 2; ++i) { const int q = tid + 256 * i, r = q >> 3, kc = q & 7; rbX[i] = *(const bf16x8*)(p.XDTT + (((long)b * 16 + h) * 64 + r) * SEQ + c * 256 + (jb + 1) * 64 + kc * 8); }
            }
            if (jb * 64 <= l0 + 31) {
#pragma unroll
                for (int nh = 0; nh < 2; ++nh) {
                    f32x4 S[2][2];
#pragma unroll
                    for (int mi = 0; mi < 2; ++mi)
#pragma unroll
                        for (int n2 = 0; n2 < 2; ++n2) S[mi][n2] = (f32x4){0.f, 0.f, 0.f, 0.f};
#pragma unroll
                    for (int ks = 0; ks < 4; ++ks)
#pragma unroll
                        for (int n2 = 0; n2 < 2; ++n2) {
                            const bf16x8 bf = *(const bf16x8*)(sB + ((nh * 2 + n2) * 16 + fr) * 272 + ks * 64 + fq * 16);
#pragma unroll
                            for (int mi = 0; mi < 2; ++mi) S[mi][n2] = __builtin_amdgcn_mfma_f32_16x16x32_bf16(bf, cf[mi][ks], S[mi][n2], 0, 0, 0);
                        }
#pragma unroll
                    for (int n2 = 0; n2 < 2; ++n2) {
                        const int n = nh * 2 + n2, s0 = jb * 64 + n * 16 + fq * 4;
                        const f32x4 as4 = *(const f32x4*)(sacs + s0);
#pragma unroll
                        for (int mi = 0; mi < 2; ++mi) {
                            const int l = l0 + mi * 16 + fr;
                            float v[4];
#pragma unroll
                            for (int j = 0; j < 4; ++j) v[j] = (s0 + j <= l) ? S[mi][n2][j] * __expf(al[mi] - as4[j]) : 0.f;
                            u32x2 w; w.x = pack2(v[0], v[1]); w.y = pack2(v[2], v[3]);
                            *(u32x2*)(sM + (mi * 16 + fr) * 144 + (n * 16 + fq * 4) * 2) = w;
                        }
                    }
                }
                asm volatile("s_waitcnt lgkmcnt(0)" ::: "memory");
#pragma unroll
                for (int ks = 0; ks < 2; ++ks) {
                    bf16x8 mf[2];
#pragma unroll
                    for (int mi = 0; mi < 2; ++mi) mf[mi] = *(const bf16x8*)(sM + (mi * 16 + fr) * 144 + ks * 64 + fq * 16);
#pragma unroll
                    for (int np = 0; np < 4; ++np) {
                        const bf16x8 xf = *(const bf16x8*)(sX + (np * 16 + fr) * 144 + ks * 64 + fq * 16);
#pragma unroll
                        for (int mi = 0; mi < 2; ++mi) y[mi][np] = __builtin_amdgcn_mfma_f32_16x16x32_bf16(xf, mf[mi], y[mi][np], 0, 0, 0);
                    }
                }
            }
            __syncthreads();
        }
        const float Dh = p.ssd_d[h];
#pragma unroll
        for (int mi = 0; mi < 2; ++mi) {
            const long t = tok0 + l0 + mi * 16 + fr;
            float ss = 0.f;
#pragma unroll
            for (int np = 0; np < 4; ++np) {
                const int col = h * 64 + np * 16 + fq * 4;
                const u32x2 xr = *(const u32x2*)(p.XN + t * 1024 + col), zr = *(const u32x2*)(p.Z + t * 1024 + col);
                float o[4];
#pragma unroll
                for (int j = 0; j < 4; ++j) {
                    const unsigned xw = (j < 2) ? xr.x : xr.y, zw = (j < 2) ? zr.x : zr.y;
                    const float xv = bf2f((bf16_t)((j & 1) ? (xw >> 16) : (xw & 0xffffu))), zv = bf2f((bf16_t)((j & 1) ? (zw >> 16) : (zw & 0xffffu)));
                    o[j] = (y[mi][np][j] + Dh * xv) * siluf_(zv);
                    ss += o[j] * o[j];
                }
                u32x2 w; w.x = pack2(o[0], o[1]); w.y = pack2(o[2], o[3]);
                *(u32x2*)(p.YG + pkl(t, col, 32)) = w;
            }
            ss = sum_fq(ss);
            if (fq == 0) p.SSQ[t * 16 + h] = ss;
        }
        return;
    }
}
DEV void phase5glu(CParams& p, int mt, int nt, char* smem) {
    {
        GRow<4> al; al.initp(p.G5, 16, (long)mt * 256, false);
        GRow<2> bl; bl.initp(p.WGLUT, 16, (long)nt * 128, true);
        f32x4 acc[8][4]; zero_acc(acc);
        gemm_loop(smem, al, bl, 16, acc);
        epi_rows(acc, [&](int r, int c0, const Row16& v) __attribute__((always_inline)) {
            const long t = (long)mt * 256 + r; const int col = nt * 128 + c0;
            float gv[16], bb[16], o[16];
            ld16_bf16(p.G5 + pkl(t, col, 16), gv);
            ld16_f32(p.b_glu + col, bb);
            float ss = 0.f;
#pragma unroll
            for (int q = 0; q < 16; ++q) { o[q] = gv[q] * sigmoidf_(v.get(q) + bb[q]); ss += o[q] * o[q]; }
            st16_bf16(p.Y5 + pkl(t, col, 16), o);
            ss = sum_fq(ss);
            if ((TIDX & 63) < 16) p.SSQ[(long)T_TOK * 16 + t * 8 + nt * 2 + (c0 >> 6)] = ss;
        });
    }
}

constexpr int P6_TASKS = 64 * 8;
DEV void phase6(CParams& p, int mt, int nt, char* smem) {
    float* srs = (float*)(smem + GEMM_SMEM);
    {
        const int r = TIDX; const long t = (long)mt * 256 + r;
        float s1 = 0.f, s2 = 0.f;
#pragma unroll
        for (int q = 0; q < 16; ++q) s1 += p.SSQ[t * 16 + q];
#pragma unroll
        for (int q = 0; q < 8; ++q) s2 += p.SSQ[(long)T_TOK * 16 + t * 8 + q];
        const float r1 = rsqrtf(s1 * (1.f / 1024.f) + 1e-6f), r2 = rsqrtf(s2 * (1.f / 512.f) + 1e-6f);
        srs[r] = r1 / r2; srs[256 + r] = r2;
    }
    __syncthreads();
    f32x4 acc[8][4]; zero_acc(acc);
    {
        GRow<4> al; al.initp(p.YG, 32, (long)mt * 256, false);
        GRow<2> bl; bl.initp(p.WOUTT, 48, (long)nt * 128, true);
        gemm_loop<true>(smem, al, bl, 32, acc);
    }
    {
        const int lane = TIDX & 63, wr = TIDX >> 7, fr = lane & 15;
#pragma unroll
        for (int m = 0; m < 8; ++m) {
            const float sc = srs[wr * 128 + m * 16 + fr];
#pragma unroll
            for (int n = 0; n < 4; ++n) acc[m][n] *= sc;
        }
    }
    {
        GRow<4> al; al.initp(p.Y5, 16, (long)mt * 256, false);
        GRow<2> bl; bl.initp(p.WOUTT, 48, (long)nt * 128, true, 32);
        gemm_loop<true>(smem, al, bl, 16, acc);
    }
    epi_rows(acc, [&](int r, int c0, const Row16& v) __attribute__((always_inline)) {
        const long t = (long)mt * 256 + r; const int col = nt * 128 + c0, b = (int)(t >> 13);
        const float r2 = srs[256 + r];
        float xv[16], gv[16], o[16];
        ld16_f32(p.x + t * 1024 + col, xv);
        ld16_f32(p.MOD + b * 6144 + 2048 + col, gv);
        float ss = 0.f;
#pragma unroll
        for (int q = 0; q < 16; ++q) { o[q] = xv[q] + gv[q] * (v.get(q) * r2); ss += o[q] * o[q]; }
        st16_f32(p.X1 + t * 1024 + col, o);
        ss = sum_fq(ss);
        if ((TIDX & 63) < 16) p.SSQ[(long)T_TOK * 24 + t * 16 + nt * 2 + (c0 >> 6)] = ss;
    });
    __syncthreads();
}

constexpr int P7_TASKS = T_TOK / 4;
DEV void phase7(CParams& p, int task) {
    const int row = task * 4 + (TIDX >> 6), b = row >> 13;
    modnorm_row(p.X1, row, p.norm2_gain, p.MOD + b * 6144 + 4096, p.MOD + b * 6144 + 3072, p.SSQ + (long)T_TOK * 24, p.H);
}

constexpr int P8_R = 128, P8_S = 256, P8_TASKS = P8_R + P8_S;
DEV void phase8r(CParams& p, int mt, int nt, char* smem) {
    GRow<4> al; al.initp(p.H, 32, (long)mt * 256, false);
    GRow<2> bl; bl.initp(p.WRT, 32, (long)nt * 128, true);
    f32x4 acc[8][4]; zero_acc(acc);
    gemm_loop<true>(smem, al, bl, 32, acc);
    epi_rows(acc, [&](int r, int c0, const Row16& v) __attribute__((always_inline)) {
        float o[16];
#pragma unroll
        for (int q = 0; q < 16; ++q) o[q] = sigmoidf_(v.get(q));
        st16_f32(p.SCORES + ((long)mt * 256 + r) * 256 + nt * 128 + c0, o);
    });
}
DEV void phase8s(CParams& p, int mt, int nt, char* smem) {
    GRow<4> al; al.initp(p.H, 32, (long)mt * 256, false);
    GRow<2> bl; bl.initp(p.WSUPT, 32, (long)nt * 128, false);
    f32x4 acc[8][4]; zero_acc(acc);
    gemm_loop<true>(smem, al, bl, 32, acc);
    epi_rows(acc, [&](int r, int c0, const Row16& v) __attribute__((always_inline)) {
        float o[8];
#pragma unroll
        for (int q = 0; q < 8; ++q) o[q] = siluf_(v.get(q)) * v.get(8 + q);
        st8_bf16(p.HSH + pkl((long)mt * 256 + r, nt * 64 + (c0 >> 1), 8), o);
    });
}
DEV void phase8(CParams& p, char* smem) {
    const int x = blockIdx.x & 7, member = blockIdx.x >> 3, nmem = (gridDim.x - x + 7) >> 3;
    for (int j = member; j < 48; j += nmem) {
        if (j < 16) phase8r(p, x * 8 + (j & 7), j >> 3, smem);
        else phase8s(p, x * 8 + ((j - 16) & 7), (j - 16) >> 3, smem);
    }
}

constexpr int P9_TASKS = T_TOK / 32;
DEV void phase9(CParams& p, int task) {
    const int lane = TIDX & 63, t0 = (task * 4 + (TIDX >> 6)) * 8;
    int accE = 0; float accW = 0.f;
    const f32x4 bs = *(const f32x4*)(p.router_bias + lane * 4);
#pragma unroll 2
  for (int ti = 0; ti < 8; ++ti) {
    const int t = t0 + ti;
    const f32x4 s = *(const f32x4*)(p.SCORES + (long)t * 256 + lane * 4);
    float v0 = s[0] + bs[0], v1 = s[1] + bs[1], v2 = s[2] + bs[2], v3 = s[3] + bs[3];
    float m1, m2;
    { const float a = fmaxf(v0, v1), b = fminf(v0, v1), c = fmaxf(v2, v3), d = fminf(v2, v3); m1 = fmaxf(a, c); m2 = fmaxf(fminf(a, c), fmaxf(b, d)); }
#pragma unroll
    for (int off = 1; off <= 4; off <<= 1) {
        const float o1 = __shfl_xor(m1, off), o2 = __shfl_xor(m2, off);
        const float n1 = fmaxf(m1, o1), n2 = fmaxf(fminf(m1, o1), fmaxf(m2, o2));
        m1 = n1; m2 = n2;
    }
    const float gs = m1 + m2;
    const int myg = lane >> 3;
    int rank = 0;
#pragma unroll
    for (int j = 0; j < 8; ++j) { const float og = __shfl(gs, j * 8); rank += ((og > gs) || (og == gs && j < myg)) ? 1 : 0; }
    const float NEG = -__builtin_inff();
    if (rank >= 4) { v0 = NEG; v1 = NEG; v2 = NEG; v3 = NEG; }
    float wsum = 0.f, myS = 0.f; int myE = 0;
#pragma unroll
    for (int r = 0; r < 8; ++r) {
        float bv = v0; int bi = 0;
        if (v1 > bv) { bv = v1; bi = 1; }
        if (v2 > bv) { bv = v2; bi = 2; }
        if (v3 > bv) { bv = v3; bi = 3; }
        float rv = bv; int ri = lane * 4 + bi;
#pragma unroll
        for (int off = 32; off >= 1; off >>= 1) {
            const float ov = __shfl_xor(rv, off); const int oi = __shfl_xor(ri, off);
            if (ov > rv || (ov == rv && oi < ri)) { rv = ov; ri = oi; }
        }
        const int sel = ri & 3;
        const float ssel = (sel == 0) ? s[0] : (sel == 1) ? s[1] : (sel == 2) ? s[2] : s[3];
        const float sc = __shfl(ssel, ri >> 2);
        if ((ri >> 2) == lane) { if (sel == 0) v0 = NEG; else if (sel == 1) v1 = NEG; else if (sel == 2) v2 = NEG; else v3 = NEG; }
        if (lane == r) { myE = ri; myS = sc; }
        wsum += sc;
    }
    const float w = myS / wsum * 2.5f;
    const int eS = __shfl(myE, lane & 7); const float wS = __shfl(w, lane & 7);
    if ((lane >> 3) == ti) { accE = eS; accW = wS; }
  }
    {
        const int t = t0 + (lane >> 3), k = lane & 7;
        int pos = atomicAdd(&p.CNT[accE], 1);
        pos = pos < 0 ? 0 : (pos >= CAP ? CAP - 1 : pos);
        p.BTOK[(long)accE * CAP + pos] = t;
        p.ASG_E[t * 8 + k] = accE; p.ASG_P[t * 8 + k] = pos; p.ASG_W[t * 8 + k] = accW;
    }
}

DEV int pos_of_expert(int e) { return (e & 7) * 32 + (e >> 3); }
DEV int expert_of_pos(int q) { return (q & 31) * 8 + (q >> 5); }
DEV void build_tables(CParams& p, int* tab, int* scratch) {
    const int tid = TIDX;
    const int c = p.CNT[expert_of_pos(tid)];
    int* a = scratch; int* b2 = scratch + 256;
    a[tid] = (c + XM - 1) / XM; b2[tid] = c;
    __syncthreads();
    for (int off = 1; off < 256; off <<= 1) {
        const int va = (tid >= off) ? a[tid - off] : 0, vb = (tid >= off) ? b2[tid - off] : 0;
        __syncthreads();
        a[tid] += va; b2[tid] += vb;
        __syncthreads();
    }
    tab[tid + 1] = a[tid]; tab[257 + tid + 1] = b2[tid];
    if (tid == 0) { tab[0] = 0; tab[257] = 0; }
    __syncthreads();
}
DEV int rows_per_tile(int cnt, int tiles) { return (((cnt + tiles - 1) / tiles) + 31) & ~31; }
DEV void find_unit(const int* tab, int x, int NT, int u, int& q, int& nt, int& rt) {
    const int base = tab[32 * x];
    int lo = 32 * x, hi = 32 * x + 31;
    while (lo < hi) { const int mid = (lo + hi + 1) >> 1; if (NT * (tab[mid] - base) <= u) lo = mid; else hi = mid - 1; }
    q = lo;
    const int local = u - NT * (tab[q] - base), tiles = tab[q + 1] - tab[q];
    nt = local / tiles; rt = local - nt * tiles;
}

DEV void phase10(CParams& p, char* smem, bool rep) {
    int* tab = (int*)(smem + GEMM_SMEM);
    build_tables(p, tab, (int*)smem);
    const int x0 = blockIdx.x & 7;
    for (int gi = 0; gi < 8; ++gi) {
      const int x = (x0 + gi) & 7; unsigned* qh = q_head(p, 2, rep, x);
      const int U = 4 * (tab[32 * x + 32] - tab[32 * x]);
      for (;;) {
        const int u = dq_next(qh, smem); if (u >= U) break;
        int q, nt, rt; find_unit(tab, x, 4, u, q, nt, rt);
        const int e = expert_of_pos(q);
        const int cnt = tab[257 + q + 1] - tab[257 + q], rpt = rows_per_tile(cnt, tab[q + 1] - tab[q]);
        const int row0 = rt * rpt, s0 = tab[257 + q] + row0, valid = min(rpt, cnt - row0);
        XGather al; al.base = (const char*)p.H; al.kstb = 128u;
        {
            const int kcs = gather_kcs();
#pragma unroll
            for (int i = 0; i < 5; ++i) { const int r = (TIDX >> 2) + 64 * i; const int tok = (r < valid) ? p.BTOK[(long)e * CAP + row0 + r] : 0; al.off[i] = (unsigned)(pkl(tok, 0, 32) * 2) + (unsigned)kcs * 2u; }
        }
        int mat, jcol; up_row_map(nt, (TIDX & 31) * 4, mat, jcol);
        ColF32<256> bl; bl.colp = (mat ? p.w3 : p.w1) + (long)e * 262144 + jcol;
        f32x4 acc[10][4]; zero_acc10(acc);
        gemm_loop_x(smem, al, bl, 32, valid, acc);
        bf16_t* hid_dst = rep ? (bf16_t*)p.OUTR : p.HID;
        epi_rows10(acc, [&](int r, int c0, const Row16& v) __attribute__((always_inline)) {
            if (r < valid) {
                float o[8];
#pragma unroll
                for (int qq = 0; qq < 8; ++qq) o[qq] = siluf_(v.get(qq)) * v.get(8 + qq);
                st8_bf16(hid_dst + pkl(s0 + r, nt * 64 + (c0 >> 1), 8), o);
            }
        });
      }
    }
}

DEV void phase10b(CParams& p, char* smem) {
    for (int idx = 0;; ++idx) {
        int mt, nt; if (!xcd_tile(idx, 64, 8, mt, nt)) break;
        GRow<4> al; al.initp(p.HSH, 8, (long)mt * 256, false);
        GRow<2> bl; bl.initp(p.WS2T, 8, (long)nt * 128, true);
        f32x4 acc[8][4]; zero_acc(acc);
        gemm_loop<true>(smem, al, bl, 8, acc);
        epi_rows(acc, [&](int r, int c0, const Row16& v) __attribute__((always_inline)) {
            const long t = (long)mt * 256 + r; const int col = nt * 128 + c0, b = (int)(t >> 13);
            float xv[16], gv[16], o[16];
            ld16_f32(p.X1 + t * 1024 + col, xv);
            ld16_f32(p.MOD + b * 6144 + 5120 + col, gv);
#pragma unroll
            for (int qq = 0; qq < 16; ++qq) o[qq] = xv[qq] + gv[qq] * v.get(qq);
            st16_f32(p.X1 + t * 1024 + col, o);
        });
    }
}

DEV void phase11(CParams& p, char* smem, bool rep) {
    int* tab = (int*)(smem + GEMM_SMEM);
    build_tables(p, tab, (int*)smem);
    const int x0 = blockIdx.x & 7;
    for (int gi = 0; gi < 8; ++gi) {
      const int x = (x0 + gi) & 7; unsigned* qh = q_head(p, 3, rep, x);
      const int U = 8 * (tab[32 * x + 32] - tab[32 * x]);
      for (;;) {
        const int u = dq_next(qh, smem); if (u >= U) break;
        int q, nt, rt; find_unit(tab, x, 8, u, q, nt, rt);
        const int e = expert_of_pos(q);
        const int cnt = tab[257 + q + 1] - tab[257 + q], rpt = rows_per_tile(cnt, tab[q + 1] - tab[q]);
        const int row0 = rt * rpt, s0 = tab[257 + q] + row0, valid = min(rpt, cnt - row0);
        XGather al; al.base = (const char*)p.HID; al.kstb = 128u;
        {
            const int kcs = gather_kcs();
#pragma unroll
            for (int i = 0; i < 5; ++i) al.off[i] = (unsigned)(pkl(s0 + (int)(TIDX >> 2) + 64 * i, 0, 8) * 2) + (unsigned)kcs * 2u;
        }
        ColF32<1024> bl; bl.colp = p.w2 + (long)e * 262144 + nt * 128 + bcol((TIDX & 31) * 4);
        f32x4 acc[10][4]; zero_acc10(acc);
        gemm_loop_x(smem, al, bl, 8, valid, acc);
        epi_rows10(acc, [&](int r, int c0, const Row16& v) __attribute__((always_inline)) {
            if (r < valid) st16_bf16(p.OUTR + (long)(s0 + r) * 1024 + nt * 128 + c0, v);
        });
      }
    }
}

DEV void phase12(CParams& p, char* smem) {
    int* tab = (int*)(smem + GEMM_SMEM);
    build_tables(p, tab, (int*)smem);
    const int lane = TIDX & 63;
    for (int task = blockIdx.x; task < T_TOK / 4; task += gridDim.x) {
        const int t = task * 4 + (TIDX >> 6), b = t >> 13;
        float a[16];
#pragma unroll
        for (int i = 0; i < 16; ++i) a[i] = 0.f;
#pragma unroll
        for (int k = 0; k < 8; ++k) {
            const int e = p.ASG_E[t * 8 + k], pos = p.ASG_P[t * 8 + k];
            const float w = p.ASG_W[t * 8 + k];
            const bf16_t* row = p.OUTR + (long)(tab[257 + pos_of_expert(e)] + pos) * 1024;
#pragma unroll
            for (int hh = 0; hh < 2; ++hh) {
                const bf16x8 v = *(const bf16x8*)(row + hh * 512 + lane * 8);
#pragma unroll
                for (int q = 0; q < 8; ++q) a[hh * 8 + q] += w * bf2f((bf16_t)v[q]);
            }
        }
        float ss = 0.f;
#pragma unroll
        for (int hh = 0; hh < 2; ++hh) {
            const int c0 = hh * 512 + lane * 8;
            const f32x4 x0 = *(const f32x4*)(p.X1 + (long)t * 1024 + c0), x1 = *(const f32x4*)(p.X1 + (long)t * 1024 + c0 + 4);
            const f32x4 g0 = *(const f32x4*)(p.MOD + b * 6144 + 5120 + c0), g1 = *(const f32x4*)(p.MOD + b * 6144 + 5120 + c0 + 4);
#pragma unroll
            for (int q = 0; q < 4; ++q) { a[hh * 8 + q] = x0[q] + g0[q] * a[hh * 8 + q]; a[hh * 8 + 4 + q] = x1[q] + g1[q] * a[hh * 8 + 4 + q]; }
#pragma unroll
            for (int q = 0; q < 8; ++q) ss += a[hh * 8 + q] * a[hh * 8 + q];
        }
        ss = wave_sum(ss);
        const float rstd = rsqrtf(ss * (1.f / 1024.f) + 1e-6f);
#pragma unroll
        for (int hh = 0; hh < 2; ++hh) {
            const int c0 = hh * 512 + lane * 8;
            const f32x4 g0 = *(const f32x4*)(p.final_gain + c0), g1 = *(const f32x4*)(p.final_gain + c0 + 4);
            f32x4 o0, o1;
#pragma unroll
            for (int q = 0; q < 4; ++q) { o0[q] = a[hh * 8 + q] * rstd * g0[q]; o1[q] = a[hh * 8 + 4 + q] * rstd * g1[q]; }
            *(f32x4*)(p.out + (long)t * 1024 + c0) = o0; *(f32x4*)(p.out + (long)t * 1024 + c0 + 4) = o1;
        }
    }
}

DEV void run_p1(CParams& p, char* smem, bool rep) {
    const int x0 = blockIdx.x & 7;
    for (int gi = 0; gi < 8; ++gi) {
        const int x = (x0 + gi) & 7; unsigned* q = q_head(p, 0, rep, x);
        for (;;) { const int j = dq_next(q, smem); if (j >= 8 * 29) break; phase1(p, x * 8 + (j & 7), j >> 3, smem, rep); }
    }
    if (!rep) { unsigned* q = q_head(p, 5, rep, 0); for (;;) { const int j = dq_next(q, smem); if (j >= P0B_TOEP) break; phase0b_toep(p, j); } }
}
DEV void run_p0(CParams& p, char* smem, bool rep) {
    unsigned* modcnt = q_head(p, 4, rep, 0);
    for (int t = blockIdx.x; t < P0_TASKS; t += gridDim.x) phase0(p, t, smem, modcnt);
    __syncthreads();
    if (TIDX == 0) {
        unsigned sp = 0;
        while (__hip_atomic_load(modcnt, __ATOMIC_RELAXED, __HIP_MEMORY_SCOPE_AGENT) < (unsigned)P0_MOD) { __builtin_amdgcn_s_sleep(2); if (++sp > (1u << 22)) break; }
        __builtin_amdgcn_fence(__ATOMIC_ACQUIRE, "agent");
        asm volatile("s_waitcnt vmcnt(0)" ::: "memory");
    }
    __syncthreads();
    for (int t = blockIdx.x; t < P0B_ROWS; t += gridDim.x) phase0b_rows(p, t);
}
DEV void run_p5(CParams& p, char* smem, bool rep) {
    {
        unsigned* q = q_head(p, 1, rep, 0);
        for (;;) { const int j = dq_next(q, smem); if (j >= P5_SSD) break; phase5(p, ((j & 1023) << 1) | ((j >> 10) ^ 1), smem); }
    }
    {
        unsigned* q = q_head(p, 1, rep, 1);
        for (;;) { const int g = dq_next(q, smem); if (g >= 256) break; phase5glu(p, g >> 2, g & 3, smem); }
    }
}
DEV void run_p2(CParams& p, char* smem) {
    for (int t = blockIdx.x; t < P2_CONV; t += gridDim.x) phase2(p, t, smem);
    for (int t = blockIdx.x; t < P2_E; t += gridDim.x) phase2e5(p, t, smem);
}
DEV void run_p6(CParams& p, char* smem) { for (int i = 0;; ++i) { int mt, nt; if (!xcd_tile(i, 64, 8, mt, nt)) break; phase6(p, mt, nt, smem); } }

__global__ void __launch_bounds__(256, 2) fwd_kernel(Params p0) {
    extern __shared__ __attribute__((aligned(16))) char smem[];
    const bool multi = (p0.phase_hi - p0.phase_lo) > 1;
    if (multi) {
        if (TIDX == 0) { *(uint4*)(smem + SMEM_BYTES - 16) = make_uint4(0u, 0u, 0u, 0u); }
        __syncthreads();
        (void)xcd_barrier_post(p0.bar, (volatile LAS unsigned*)(smem + SMEM_BYTES - 16));
    }
#define XB_NOW() ({ XcdBarrier xb_; xb_.bar = ((CParams*)__builtin_amdgcn_kernarg_segment_ptr())->bar; xb_.x = xb_xcc_id(); xb_.st = (volatile LAS unsigned*)(smem + SMEM_BYTES - 16); xb_; })
    const int lo = p0.phase_lo, hi = p0.phase_hi, rp_ = p0.repeat_phase;
#define PH_RUN(n, body) if (lo <= (n) && (n) < hi) { const int nrep_ = ((n) == rp_) ? 2 : 1; for (int rep_ = 0; rep_ < nrep_; ++rep_) { if ((n) > lo || rep_ > 0) xcd_barrier(XB_NOW()); const bool rep = rep_ > 0; (void)rep; CParams* pp_ = (CParams*)__builtin_amdgcn_kernarg_segment_ptr(); asm volatile("" : "+s"(pp_)); CParams& p = *pp_; body } }
    PH_RUN(0, run_p0(p, smem, rep);)
    PH_RUN(2, run_p1(p, smem, rep);)
    PH_RUN(3, run_p2(p, smem);)
    PH_RUN(4, for (int t = blockIdx.x; t < P3_TASKS; t += gridDim.x) phase3(p, t, smem);)
    PH_RUN(5, for (int t = blockIdx.x; t < P4_TASKS; t += gridDim.x) phase4(p, t, smem);)
    PH_RUN(6, run_p5(p, smem, rep);)
    PH_RUN(7, run_p6(p, smem);)
    PH_RUN(8, for (int t = blockIdx.x; t < P7_TASKS; t += gridDim.x) phase7(p, t);)
    PH_RUN(9, phase8(p, smem);)
    PH_RUN(10, for (int t = blockIdx.x; t < P9_TASKS; t += gridDim.x) phase9(p, t);)
    PH_RUN(11, phase10(p, smem, rep); if (!rep) { CParams* q_ = (CParams*)__builtin_amdgcn_kernarg_segment_ptr(); asm volatile("" : "+s"(q_)); phase10b(*q_, smem); })
    PH_RUN(12, phase11(p, smem, rep);)
    PH_RUN(13, phase12(p, smem);)
}
constexpr int N_PH = 14;
static inline size_t al256(size_t v) { return (v + 255) & ~(size_t)255; }
extern "C" void kernel_launch(void* const* d_in, const int* in_sizes, int n_in, void* d_out, int out_size, void* d_ws, size_t ws_size, hipStream_t stream) {
    (void)in_sizes; (void)n_in; (void)out_size;
    Params p;
    ::memset((void*)&p, 0, sizeof(p));
    const float** ins = (const float**)&p.x;
    for (int i = 0; i < 34; ++i) ins[i] = (const float*)d_in[i];
    p.out = (float*)d_out;
    char* w = (char*)d_ws; size_t o = 0;
    auto carve = [&](size_t bytes) __attribute__((always_inline)) { char* r = w + o; o = al256(o + bytes); return r; };
    p.bar = (unsigned*)carve((XCD_BAR_WORDS + Q_WORDS) * 4);
    p.MOD = (float*)carve(2 * 6144 * 4);
    p.H = (bf16_t*)carve((size_t)T_TOK * 1024 * 2);
    p.WINT = (bf16_t*)carve((size_t)NPROJ_PAD * 1024 * 2);
    p.WOUTT = (bf16_t*)carve((size_t)1024 * 1536 * 2);
    p.WGLUT = (bf16_t*)carve((size_t)512 * 512 * 2);
    p.WRT = (bf16_t*)carve((size_t)256 * 1024 * 2);
    p.WSUPT = (bf16_t*)carve((size_t)512 * 1024 * 2);
    p.WS2T = (bf16_t*)carve((size_t)1024 * 256 * 2);
    p.KERN = (float*)carve((size_t)32 * 32 * 256 * 4);
    p.W5T = (bf16_t*)carve((size_t)32 * 512 * 640 * 2);
    p.E5T = (bf16_t*)carve((size_t)32 * 128 * 512 * 2);
    p.AQ = (float*)carve((size_t)32 * 64 * 2 * 4);
    p.Z = (bf16_t*)carve((size_t)T_TOK * 1024 * 2);
    p.XBCR = (bf16_t*)carve((size_t)T_TOK * 2048 * 2);
    p.DTR = (float*)carve((size_t)T_TOK * 16 * 4);
    p.UG = (bf16_t*)carve((size_t)32 * T_TOK * 16 * 2);
    p.XN = (bf16_t*)carve((size_t)T_TOK * 1024 * 2);
    p.BN = (bf16_t*)carve((size_t)T_TOK * 512 * 2);
    p.CN = (bf16_t*)carve((size_t)T_TOK * 512 * 2);
    p.XDTT = (bf16_t*)carve((size_t)T_TOK * 1024 * 2);
    p.XDECT = (bf16_t*)carve((size_t)T_TOK * 1024 * 2);
    p.BT = (bf16_t*)carve((size_t)T_TOK * 512 * 2);
    p.ACS = (float*)carve((size_t)2 * 16 * SEQ * 4);
    p.ST = (float*)carve((size_t)2 * 32 * 16 * 64 * 128 * 4);
    p.PREV = (bf16_t*)carve((size_t)2 * 32 * 16 * 64 * 128 * 2);
    p.E5 = (float*)carve((size_t)32 * 512 * 128 * 4);
    p.SPREV = (bf16_t*)carve((size_t)32 * 512 * 128 * 2);
    p.G5 = (bf16_t*)carve((size_t)T_TOK * 512 * 2);
    p.Y5 = (bf16_t*)carve((size_t)T_TOK * 512 * 2);
    p.YG = (bf16_t*)carve((size_t)T_TOK * 1024 * 2);
    p.SSQ = (float*)carve((size_t)T_TOK * 40 * 4);
    p.CNT = (int*)carve(256 * 4);
    p.X1 = (float*)carve((size_t)T_TOK * 1024 * 4);
    p.SCORES = (float*)carve((size_t)T_TOK * 256 * 4);
    p.BTOK = (int*)carve((size_t)NEXP * CAP * 4);
    p.ASG_E = (int*)carve((size_t)T_TOK * 8 * 4);
    p.ASG_P = (int*)carve((size_t)T_TOK * 8 * 4);
    p.ASG_W = (float*)carve((size_t)T_TOK * 8 * 4);
    p.HSH = (bf16_t*)carve((size_t)T_TOK * 256 * 2);
    p.HID = (bf16_t*)carve((size_t)(NSLOT + 320) * 256 * 2);
    p.OUTR = (bf16_t*)carve((size_t)(NSLOT + 320) * 1024 * 2);
    p.DBG = (float*)carve(1024);
    if (o > ws_size) { fprintf(stderr, "workspace too small: need %zu have %zu\n", o, ws_size); return; }

    static int grid_blocks = 0;
    if (!grid_blocks) {
        int dev = 0, cus = 0, per_cu = 0;
        if (hipGetDevice(&dev) != hipSuccess || hipDeviceGetAttribute(&cus, hipDeviceAttributeMultiprocessorCount, dev) != hipSuccess) { fprintf(stderr, "kernel_launch: device query failed\n"); grid_blocks = -1; return; }
        if (hipFuncSetAttribute((const void*)fwd_kernel, hipFuncAttributeMaxDynamicSharedMemorySize, SMEM_BYTES) != hipSuccess) { fprintf(stderr, "kernel_launch: hipFuncSetAttribute failed\n"); grid_blocks = -1; return; }
        if (hipOccupancyMaxActiveBlocksPerMultiprocessor(&per_cu, (const void*)fwd_kernel, 256, SMEM_BYTES) != hipSuccess || per_cu < 1) { fprintf(stderr, "kernel_launch: occupancy query says %d\n", per_cu); per_cu = 1; }
        (void)hipGetLastError();
        if (per_cu > 2) per_cu = 2;
        grid_blocks = cus * per_cu;
    }
    if (grid_blocks < 0) return;
#if MULTI_LAUNCH
    (void)hipMemsetAsync(p.bar, 0, (XCD_BAR_WORDS + Q_WORDS) * 4, stream);
    for (int ph = 0; ph < N_PH && ph < MAX_PHASE; ++ph) {
        p.phase_lo = ph; p.phase_hi = ph + 1; p.repeat_phase = -1;
        hipLaunchKernelGGL(fwd_kernel, dim3(grid_blocks), dim3(256), SMEM_BYTES, stream, p);
    }
#else
    (void)hipMemsetAsync(p.bar, 0, (XCD_BAR_WORDS + Q_WORDS) * 4, stream);
    p.phase_lo = 0; p.phase_hi = N_PH; p.repeat_phase = REPEAT_PHASE;
    hipLaunchKernelGGL(fwd_kernel, dim3(grid_blocks), dim3(256), SMEM_BYTES, stream, p);
#endif
}
```

```cpp
#include <hip/hip_runtime.h>
#include <stdint.h>
#include <stdio.h>
#include <string.h>

#ifndef MULTI_LAUNCH
#define MULTI_LAUNCH 0
#endif
#ifndef MAX_PHASE
#define MAX_PHASE 99
#endif
#ifndef REPEAT_PHASE
#define REPEAT_PHASE -1
#endif
#ifndef PROBE_VARIANT
#define PROBE_VARIANT 0
#endif

#define DEV __device__ __forceinline__
#define LAS __attribute__((address_space(3)))
typedef unsigned short bf16_t;
typedef short bf16x8 __attribute__((ext_vector_type(8)));
typedef float f32x4 __attribute__((ext_vector_type(4)));
typedef unsigned u32x2 __attribute__((ext_vector_type(2)));
typedef unsigned u32x4 __attribute__((ext_vector_type(4)));

__device__ __forceinline__ unsigned tid_v_() { unsigned t = __builtin_amdgcn_workitem_id_x(); asm volatile("" : "+v"(t)); return t; }
#define TIDX (tid_v_())

constexpr int T_TOK = 16384, SEQ = 8192, DM = 1024;
constexpr int NPROJ = 3600, NPROJ_PAD = 3712;
constexpr int NEXP = 256, CAP = 16384, NSLOT = T_TOK * 8;
constexpr int S5Q = 32;
constexpr int NPHASE = 13;

typedef __bf16 hbf2 __attribute__((ext_vector_type(2)));
typedef float f32x2 __attribute__((ext_vector_type(2)));
DEV bf16_t f2bf(float f) { const __bf16 b = (__bf16)f; return __builtin_bit_cast(bf16_t, b); }
DEV float bf2f(bf16_t h) { return __uint_as_float(((unsigned)h) << 16); }
DEV unsigned pack2(float lo, float hi) { const f32x2 v = {lo, hi}; const hbf2 b = __builtin_convertvector(v, hbf2); return __builtin_bit_cast(unsigned, b); }
DEV float sigmoidf_(float v) { return __builtin_amdgcn_rcpf(1.f + __expf(-v)); }
DEV float siluf_(float v) { return v * __builtin_amdgcn_rcpf(1.f + __expf(-v)); }
DEV float gelu_tanh(float v) { float u = 0.7978845608028654f * (v + 0.044715f * v * v * v); float th = 1.f - 2.f * __builtin_amdgcn_rcpf(1.f + __expf(2.f * u)); return 0.5f * v * (1.f + th); }
DEV float wave_sum(float v) {
#pragma unroll
    for (int o = 32; o >= 1; o >>= 1) v += __shfl_xor(v, o);
    return v;
}

#define XB_TMO      128
#define XB_XCNT(j)  (256  + 64 * (j))
#define XB_XSUB(j)  (1280 + 64 * (j))
#define XB_XGEN(j)  (2304 + 64 * (j))
#define XB_TOP      3328
#define XB_TOPGEN   3392
#define XCD_BAR_WORDS 3456
#define XB_SPIN_CAP (1u << 20)
DEV unsigned xb_ld(unsigned* p) { return __hip_atomic_load(p, __ATOMIC_RELAXED, __HIP_MEMORY_SCOPE_AGENT); }
DEV unsigned xb_add(unsigned* p, unsigned v) { return __hip_atomic_fetch_add(p, v, __ATOMIC_RELAXED, __HIP_MEMORY_SCOPE_AGENT); }
DEV unsigned xb_xcc_id() { return (unsigned)__builtin_amdgcn_s_getreg((3 << 11) | 20) & 0xFu; }
#define XB_SPIN(cond, bar) do { unsigned _sp = 0; while (cond) { __builtin_amdgcn_s_sleep(1); \
    if ((++_sp & 255u) == 0u) { if (xb_ld(&(bar)[XB_TMO])) break; if (_sp > XB_SPIN_CAP) { atomicAdd(&(bar)[XB_TMO], 1u); break; } } } } while (0)
struct XcdBarrier { unsigned* bar; unsigned x; volatile LAS unsigned* st; };
DEV XcdBarrier xcd_barrier_post(unsigned* bar, volatile LAS unsigned* st) {
    XcdBarrier b; b.bar = bar; b.x = xb_xcc_id(); b.st = st;
    if (TIDX == 0) (void)xb_add(&bar[XB_XCNT(b.x)], 1u);
    return b;
}
DEV void xcd_barrier_complete(unsigned* bar, unsigned x, unsigned& nloc, unsigned& nx) {
    const unsigned G = gridDim.x * gridDim.y * gridDim.z;
    unsigned sum, cnt, mine, sp = 0u;
    for (;;) {
        sum = 0u; cnt = 0u; mine = 0u;
#pragma unroll
        for (unsigned j = 0; j < 16; ++j) { const unsigned c = xb_ld(&bar[XB_XCNT(j)]); sum += c; cnt += (c > 0u) ? 1u : 0u; mine = (j == x) ? c : mine; }
        if (sum == G) break;
        __builtin_amdgcn_s_sleep(1);
        if ((++sp & 255u) == 0u) { if (xb_ld(&bar[XB_TMO])) break; if (sp > XB_SPIN_CAP) { atomicAdd(&bar[XB_TMO], 1u); break; } }
    }
    nloc = mine > 0u ? mine : 1u; nx = cnt > 0u ? cnt : 1u;
}
DEV void xcd_barrier(const XcdBarrier& b) {
    asm volatile("s_waitcnt vmcnt(0)" ::: "memory");
    __syncthreads();
    if (TIDX == 0) {
        unsigned* bar = b.bar;
        __builtin_amdgcn_s_waitcnt(0);
        unsigned nloc = b.st[0], nx = b.st[1];
        if (nloc == 0u) { xcd_barrier_complete(bar, b.x, nloc, nx); b.st[0] = nloc; b.st[1] = nx; }
        const unsigned old = xb_add(&bar[XB_XSUB(b.x)], 1u);
        const unsigned gen = old / nloc;
        if (old + 1u == (gen + 1u) * nloc) {
            __builtin_amdgcn_fence(__ATOMIC_RELEASE, "agent");
            asm volatile("s_waitcnt vmcnt(0)" ::: "memory");
            const unsigned og = xb_add(&bar[XB_TOP], 1u);
            const unsigned tg = og / nx;
            if (og + 1u == (tg + 1u) * nx) xb_add(&bar[XB_TOPGEN], 1u);
            else XB_SPIN(xb_ld(&bar[XB_TOPGEN]) == tg, bar);
            __builtin_amdgcn_fence(__ATOMIC_ACQUIRE, "agent");
            xb_add(&bar[XB_XGEN(b.x)], 1u);
            asm volatile("s_waitcnt vmcnt(0)" ::: "memory");
        } else {
            XB_SPIN(xb_ld(&bar[XB_XGEN(b.x)]) == gen, bar);
            __builtin_amdgcn_fence(__ATOMIC_ACQUIRE, "agent");
            asm volatile("s_waitcnt vmcnt(0)" ::: "memory");
        }
    }
    __syncthreads();
}

struct Params {
    const float *x, *c, *w_ada, *b_ada, *norm1_gain, *w_in, *conv_w, *conv_b, *dt_bias, *ssd_a_log, *ssd_d, *ssd_norm_gain,
        *s5_a_re, *s5_a_im, *s5_log_dt, *s5_b_re, *s5_b_im, *s5_c_re, *s5_c_im, *s5_d, *w_glu, *b_glu, *s5_norm_gain, *w_out,
        *norm2_gain, *w_router, *router_bias, *w1, *w3, *w2, *ws1, *ws3, *ws2, *final_gain;
    float* out;
    unsigned* bar;
    float* MOD;
    bf16_t* H;
    bf16_t* WINT;
    bf16_t* WOUTT;
    bf16_t* WGLUT;
    bf16_t* WRT;
    bf16_t* WSUPT;
    bf16_t* WS2T;
    float* KERN;
    bf16_t* W5T;
    bf16_t* E5T;
    float* AQ;
    bf16_t* Z;
    bf16_t* XBCR;
    float* DTR;
    bf16_t* UG;
    bf16_t* XN;
    bf16_t* BN;
    bf16_t* CN;
    bf16_t* XDTT;
    bf16_t* XDECT;
    bf16_t* BT;
    float* ACS;
    float* ST;
    bf16_t* PREV;
    float* E5;
    bf16_t* SPREV;
    bf16_t* G5;
    bf16_t* Y5;
    bf16_t* YG;
    float* SSQ;
    int* CNT;
    float* X1;
    float* SCORES;
    int* BTOK;
    int* ASG_E;
    int* ASG_P;
    float* ASG_W;
    bf16_t* HSH;
    bf16_t* HID;
    unsigned char* H2F8;
    bf16_t* OUTR;
    float* DBG;
    int phase_lo, phase_hi, repeat_phase, pad_;
};

typedef const __attribute__((address_space(4))) Params CParams;

constexpr int BK = 32, ST_A = 256 * 64, ST_B = 128 * 64, STAGE_B = ST_A + ST_B;
constexpr int GEMM_SMEM = 3 * STAGE_B;
constexpr int SMEM_BYTES = GEMM_SMEM + 4096;
DEV unsigned tid_opaque() { unsigned t = __builtin_amdgcn_workitem_id_x(); asm volatile("" : "+v"(t)); return t; }
DEV long pkl(long r, int k, int KB) { return (((r >> 1) * KB + (k >> 5)) << 6) + ((r & 1) << 5) + (k & 31); }
DEV int bcol(int R) { return (R & 64) | (((R >> 2) & 3) << 4) | (((R >> 4) & 3) << 2) | (R & 3); }
DEV int swzF(int kc) { return (0x9C >> (2 * kc)) & 3; }
DEV int swzFinv(int c) { return (0x78 >> (2 * c)) & 3; }

template <int NI> struct GRow {
    const bf16_t* p0; long s64;
    DEV void init(const bf16_t* base, long ld, bool perm) {
        const int tid = TIDX, r0 = tid >> 2, kcs = swzFinv((tid & 3) ^ ((tid >> 4) & 3));
        p0 = base + (long)(perm ? bcol(r0) : r0) * ld + kcs * 8; s64 = 64 * ld; kst = BK;
    }
    int kst;
    DEV void initp(const bf16_t* base, int KB, long row0, bool perm, int kt0 = 0) {
        const int tid = TIDX, r0 = tid >> 2, kcs = swzFinv((tid & 3) ^ ((tid >> 4) & 3));
        const int r = perm ? bcol(r0) : r0;
        p0 = base + pkl(row0 + r, kt0 * 32, KB) + kcs * 8; s64 = (long)32 * KB * 64; kst = 64;
    }
    DEV void issue(int kt, char* img) {
        char* d = img + (TIDX >> 6) * 1024;
#pragma unroll
        for (int i = 0; i < NI; ++i) __builtin_amdgcn_global_load_lds((const unsigned*)(p0 + i * s64 + (long)kt * kst), (unsigned*)(d + i * 4096), 16, 0, 0);
    }
};
struct GGather {
    const char* base; unsigned off[4];
    DEV void issue(int kt, char* img) {
        char* d = img + (TIDX >> 6) * 1024;
#pragma unroll
        for (int i = 0; i < 4; ++i) __builtin_amdgcn_global_load_lds((const unsigned*)(base + (size_t)(off[i] + (unsigned)(kt * BK * 2))), (unsigned*)(d + i * 4096), 16, 0, 0);
    }
};
DEV int gather_kcs() { return swzFinv((TIDX & 3) ^ ((TIDX >> 4) & 3)) * 8; }
template <int LDN> struct ColF32 {
    const float* colp; f32x4 v[4];
    DEV void load(int kt) {
        const float* q = colp + (long)(kt * BK + (tid_opaque() >> 5) * 4) * LDN;
#pragma unroll
        for (int e = 0; e < 4; ++e) v[e] = *(const f32x4*)(q + (long)e * LDN);
    }
    DEV void store(char* img) {
        const unsigned t_ = tid_opaque(); const int R0 = (t_ & 31) * 4, ksub = t_ >> 5, kc = ksub >> 1, half = ksub & 1;
#pragma unroll
        for (int c = 0; c < 4; ++c) {
            const int row = R0 + c;
            u32x2 w; w.x = pack2(v[0][c], v[1][c]); w.y = pack2(v[2][c], v[3][c]);
            *(u32x2*)(img + row * 64 + ((((row >> 2) & 3) ^ swzF(kc)) * 16) + half * 8) = w;
        }
    }
};
DEV void zero_acc(f32x4 (&acc)[8][4]) {
#pragma unroll
    for (int m = 0; m < 8; ++m)
#pragma unroll
        for (int n = 0; n < 4; ++n) acc[m][n] = (f32x4){0.f, 0.f, 0.f, 0.f};
}
template <bool PF> DEV void mma_stage(const char* st, int aoff, int boff, f32x4 (&acc)[8][4]) {
    bf16x8 bf[4];
#pragma unroll
    for (int n = 0; n < 4; ++n) bf[n] = *(const bf16x8*)(st + ST_A + boff + n * 1024);
    bf16x8 a0 = *(const bf16x8*)(st + aoff), a1 = *(const bf16x8*)(st + aoff + 1024);
#pragma unroll
    for (int mp = 0; mp < 4; ++mp) {
        bf16x8 n0 = a0, n1 = a1;
        if (mp < 3) { n0 = *(const bf16x8*)(st + aoff + (2 * mp + 2) * 1024); n1 = *(const bf16x8*)(st + aoff + (2 * mp + 3) * 1024); }
        if (PF) __builtin_amdgcn_sched_barrier(0);
#pragma unroll
        for (int n = 0; n < 4; ++n) acc[2 * mp][n] = __builtin_amdgcn_mfma_f32_16x16x32_bf16(bf[n], a0, acc[2 * mp][n], 0, 0, 0);
#pragma unroll
        for (int n = 0; n < 4; ++n) acc[2 * mp + 1][n] = __builtin_amdgcn_mfma_f32_16x16x32_bf16(bf[n], a1, acc[2 * mp + 1][n], 0, 0, 0);
        a0 = n0; a1 = n1;
    }
}
DEV void mma_stage_part(const char* st, int aoff, int boff, int npair, f32x4 (&acc)[8][4]) {
    if (npair <= 0) return;
    bf16x8 bf[4];
#pragma unroll
    for (int n = 0; n < 4; ++n) bf[n] = *(const bf16x8*)(st + ST_A + boff + n * 1024);
#pragma unroll
    for (int mp = 0; mp < 4; ++mp) {
        if (mp < npair) {
            const bf16x8 a0 = *(const bf16x8*)(st + aoff + (2 * mp) * 1024), a1 = *(const bf16x8*)(st + aoff + (2 * mp + 1) * 1024);
#pragma unroll
            for (int n = 0; n < 4; ++n) acc[2 * mp][n] = __builtin_amdgcn_mfma_f32_16x16x32_bf16(bf[n], a0, acc[2 * mp][n], 0, 0, 0);
#pragma unroll
            for (int n = 0; n < 4; ++n) acc[2 * mp + 1][n] = __builtin_amdgcn_mfma_f32_16x16x32_bf16(bf[n], a1, acc[2 * mp + 1][n], 0, 0, 0);
        }
    }
}
DEV void frag_offsets(int& aoff, int& boff) {
    const int lane = TIDX & 63, wid = TIDX >> 6, wr = wid >> 1, wc = wid & 1, fr = lane & 15, fq = lane >> 4;
    const int fo = (((fr >> 2) & 3) ^ swzF(fq)) * 16;
    aoff = (wr * 128 + fr) * 64 + fo; boff = (wc * 64 + fr) * 64 + fo;
}
template <bool PFX = false, class AL, class BL>
DEV void gemm_loop(char* smem, AL& al, BL& bl, int nk, f32x4 (&acc)[8][4], bool rep = false) {
    int aoff, boff; frag_offsets(aoff, boff);
    const bool noMMA = rep && (PROBE_VARIANT == 2), noB = rep && (PROBE_VARIANT == 3 || PROBE_VARIANT == 5 || PROBE_VARIANT >= 7), noA = rep && (PROBE_VARIANT == 4 || PROBE_VARIANT == 5 || PROBE_VARIANT >= 7), noBar = rep && (PROBE_VARIANT == 6 || PROBE_VARIANT == 8 || PROBE_VARIANT == 9);
    char* pc = smem; char* pn = smem + STAGE_B; char* pnn = smem + 2 * STAGE_B;
    if (!noA) al.issue(0, pc); if (!noB) bl.issue(0, pc + ST_A);
    if (!noA) al.issue(1, pn); if (!noB) bl.issue(1, pn + ST_A);
    asm volatile("s_waitcnt vmcnt(0)" ::: "memory");
    __builtin_amdgcn_s_barrier();
#pragma unroll 1
    for (int kt = 0; kt < nk; ++kt) {
        const bool more = (kt + 2 < nk);
        if (more) { if (!noA) al.issue(kt + 2, pnn); if (!noB) bl.issue(kt + 2, pnn + ST_A); }
        if (rep && (PROBE_VARIANT == 7 || PROBE_VARIANT == 9)) {
            bf16x8 fa = {1, 2, 3, 4, 5, 6, 7, 8}; asm volatile("" : "+v"(fa));
#pragma unroll
            for (int m = 0; m < 8; ++m)
#pragma unroll
                for (int n = 0; n < 4; ++n) acc[m][n] = __builtin_amdgcn_mfma_f32_16x16x32_bf16(fa, fa, acc[m][n], 0, 0, 0);
        } else if (!noMMA) mma_stage<PFX>(pc, aoff, boff, acc);
        if (rep && PROBE_VARIANT != 0 && PROBE_VARIANT != 1) { asm volatile("s_waitcnt vmcnt(0)" ::: "memory"); }
        else { if (more) asm volatile("s_waitcnt vmcnt(6)" ::: "memory"); else asm volatile("s_waitcnt vmcnt(0)" ::: "memory"); }
        asm volatile("s_waitcnt lgkmcnt(0)" ::: "memory");
        if (!noBar) __builtin_amdgcn_s_barrier();
        char* t = pc; pc = pn; pn = pnn; pnn = t;
    }
}
template <class AL, class BL>
DEV void gemm_loop_regb(char* smem, AL& al, BL& bl, int nk, int valid, f32x4 (&acc)[8][4], bool rep = false) {
    int aoff, boff; frag_offsets(aoff, boff);
    const int npair = min(4, max(0, (valid - (int)(TIDX >> 7) * 128 + 31) >> 5));
    const bool noMMA = rep && (PROBE_VARIANT == 2), noB = rep && (PROBE_VARIANT == 3), noA = rep && (PROBE_VARIANT == 4);
    char* pc = smem; char* pn = smem + STAGE_B;
    if (!noA) al.issue(0, pc); if (!noB) bl.load(0); bl.store(pc + ST_A);
    asm volatile("s_waitcnt vmcnt(0)" ::: "memory");
    __syncthreads();
#pragma unroll 1
    for (int kt = 0; kt < nk; ++kt) {
        const bool more = (kt + 1 < nk);
        if (more) { if (!noA) al.issue(kt + 1, pn); if (!noB) bl.load(kt + 1); }
        if (!noMMA) { if (npair == 4) mma_stage<false>(pc, aoff, boff, acc); else mma_stage_part(pc, aoff, boff, npair, acc); }
        if (more) bl.store(pn + ST_A);
        asm volatile("s_waitcnt vmcnt(0)" ::: "memory");
        __syncthreads();
        char* t = pc; pc = pn; pn = t;
    }
}
constexpr int XM = 320, XST_A = XM * 64, XSTAGE = XST_A + ST_B;
struct XGather {
    const char* base; unsigned off[5]; unsigned kstb;
    DEV void issue(int kt, char* img) {
        char* d = img + (TIDX >> 6) * 1024;
#pragma unroll
        for (int i = 0; i < 5; ++i) __builtin_amdgcn_global_load_lds((const unsigned*)(base + (size_t)(off[i] + (unsigned)kt * kstb)), (unsigned*)(d + i * 4096), 16, 0, 0);
    }
};
DEV void zero_acc10(f32x4 (&acc)[10][4]) {
#pragma unroll
    for (int m = 0; m < 10; ++m)
#pragma unroll
        for (int n = 0; n < 4; ++n) acc[m][n] = (f32x4){0.f, 0.f, 0.f, 0.f};
}
DEV void mma_stage10(const char* st, int aoff, int boff, int npair, f32x4 (&acc)[10][4]) {
    if (npair <= 0) return;
    bf16x8 bf[4];
#pragma unroll
    for (int n = 0; n < 4; ++n) bf[n] = *(const bf16x8*)(st + XST_A + boff + n * 1024);
#pragma unroll
    for (int mp = 0; mp < 5; ++mp) {
        if (mp < npair) {
            const bf16x8 a0 = *(const bf16x8*)(st + aoff + (2 * mp) * 1024), a1 = *(const bf16x8*)(st + aoff + (2 * mp + 1) * 1024);
#pragma unroll
            for (int n = 0; n < 4; ++n) acc[2 * mp][n] = __builtin_amdgcn_mfma_f32_16x16x32_bf16(bf[n], a0, acc[2 * mp][n], 0, 0, 0);
#pragma unroll
            for (int n = 0; n < 4; ++n) acc[2 * mp + 1][n] = __builtin_amdgcn_mfma_f32_16x16x32_bf16(bf[n], a1, acc[2 * mp + 1][n], 0, 0, 0);
        }
    }
}
template <class AL, class BL>
DEV void gemm_loop_x(char* smem, AL& al, BL& bl, int nk, int valid, f32x4 (&acc)[10][4]) {
    const int lane = TIDX & 63, wid = TIDX >> 6, wr = wid >> 1, wc = wid & 1, fr = lane & 15, fq = lane >> 4;
    const int fo = (((fr >> 2) & 3) ^ swzF(fq)) * 16;
    const int aoff = (wr * 160 + fr) * 64 + fo, boff = (wc * 64 + fr) * 64 + fo;
    const int npair = min(5, max(0, (valid - wr * 160 + 31) >> 5));
    char* pc = smem; char* pn = smem + XSTAGE;
    al.issue(0, pc); bl.load(0); bl.store(pc + XST_A);
    asm volatile("s_waitcnt vmcnt(0)" ::: "memory");
    __syncthreads();
#pragma unroll 1
    for (int kt = 0; kt < nk; ++kt) {
        const bool more = (kt + 1 < nk);
        if (more) { al.issue(kt + 1, pn); bl.load(kt + 1); }
        mma_stage10(pc, aoff, boff, npair, acc);
        if (more) bl.store(pn + XST_A);
        asm volatile("s_waitcnt vmcnt(0)" ::: "memory");
        __syncthreads();
        char* t = pc; pc = pn; pn = t;
    }
}
typedef long i64_t;
constexpr float W8_SCALE = 64.f, W8_INV = 1.f / 64.f;
DEV unsigned pack4_fp8(float a, float b, float c, float d) { int v = __builtin_amdgcn_cvt_pk_fp8_f32(a, b, 0, false); v = __builtin_amdgcn_cvt_pk_fp8_f32(c, d, v, true); return (unsigned)v; }
DEV long pkl8(long r, int k, int KB) { return (((r >> 1) * KB + (k >> 6)) << 7) + ((r & 1) << 6) + (k & 63); }
template <int LDN> struct ColF8 {
    const float* colp; f32x4 v[8];
    DEV void load(int kt) {
        const float* q = colp + (long)(kt * 64 + (tid_opaque() >> 5) * 8) * LDN;
#pragma unroll
        for (int e = 0; e < 8; ++e) v[e] = *(const f32x4*)(q + (long)e * LDN);
    }
    DEV void store(char* img) {
        const unsigned t_ = TIDX; const int R0 = (t_ & 31) * 4, ksub = t_ >> 5, kc = ksub >> 1, half = ksub & 1;
#pragma unroll
        for (int c = 0; c < 4; ++c) {
            const int row = R0 + c;
            u32x2 w;
            w.x = pack4_fp8(W8_SCALE * v[0][c], W8_SCALE * v[1][c], W8_SCALE * v[2][c], W8_SCALE * v[3][c]);
            w.y = pack4_fp8(W8_SCALE * v[4][c], W8_SCALE * v[5][c], W8_SCALE * v[6][c], W8_SCALE * v[7][c]);
            *(u32x2*)(img + row * 64 + ((((row >> 2) & 3) ^ swzF(kc)) * 16) + half * 8) = w;
        }
    }
};
DEV void mma_stage10_f8(const char* st, int rowA, int rowB, int quad, int fq, int npair, f32x4 (&acc)[10][4]) {
    if (npair <= 0) return;
#pragma unroll
    for (int ks = 0; ks < 2; ++ks) {
        const int co = ((quad ^ swzF(ks * 2 + (fq >> 1))) * 16) + (fq & 1) * 8;
        i64_t bf[4];
#pragma unroll
        for (int n = 0; n < 4; ++n) bf[n] = *(const i64_t*)(st + XST_A + rowB + co + n * 1024);
#pragma unroll
        for (int mp = 0; mp < 5; ++mp) {
            if (mp < npair) {
                const i64_t a0 = *(const i64_t*)(st + rowA + co + (2 * mp) * 1024), a1 = *(const i64_t*)(st + rowA + co + (2 * mp + 1) * 1024);
#pragma unroll
                for (int n = 0; n < 4; ++n) acc[2 * mp][n] = __builtin_amdgcn_mfma_f32_16x16x32_fp8_fp8(bf[n], a0, acc[2 * mp][n], 0, 0, 0);
#pragma unroll
                for (int n = 0; n < 4; ++n) acc[2 * mp + 1][n] = __builtin_amdgcn_mfma_f32_16x16x32_fp8_fp8(bf[n], a1, acc[2 * mp + 1][n], 0, 0, 0);
            }
        }
    }
}
template <class AL, class BL>
DEV void gemm_loop_x8(char* smem, AL& al, BL& bl, int nk, int valid, f32x4 (&acc)[10][4]) {
    const int lane = TIDX & 63, wid = TIDX >> 6, wr = wid >> 1, wc = wid & 1, fr = lane & 15, fq = lane >> 4;
    const int rowA = (wr * 160 + fr) * 64, rowB = (wc * 64 + fr) * 64, quad = (fr >> 2) & 3;
    const int npair = min(5, max(0, (valid - wr * 160 + 31) >> 5));
    char* pc = smem; char* pn = smem + XSTAGE;
    al.issue(0, pc); bl.load(0); bl.store(pc + XST_A);
    asm volatile("s_waitcnt vmcnt(0)" ::: "memory");
    __syncthreads();
#pragma unroll 1
    for (int kt = 0; kt < nk; ++kt) {
        const bool more = (kt + 1 < nk);
        if (more) { al.issue(kt + 1, pn); bl.load(kt + 1); }
        mma_stage10_f8(pc, rowA, rowB, quad, fq, npair, acc);
        if (more) bl.store(pn + XST_A);
        asm volatile("s_waitcnt vmcnt(0)" ::: "memory");
        __syncthreads();
        char* t = pc; pc = pn; pn = t;
    }
}
struct Row16 {
    f32x4 a0, a1, a2, a3;
    DEV float get(int q) const { return (q < 4) ? a0[q & 3] : (q < 8) ? a1[q & 3] : (q < 12) ? a2[q & 3] : a3[q & 3]; }
};
template <class F> DEV void epi_rows(const f32x4 (&acc)[8][4], F fn) {
    const int lane = TIDX & 63, wid = TIDX >> 6, wr = wid >> 1, wc = wid & 1, fr = lane & 15, fq = lane >> 4;
#pragma unroll
    for (int m = 0; m < 8; ++m) {
        Row16 v; v.a0 = acc[m][0]; v.a1 = acc[m][1]; v.a2 = acc[m][2]; v.a3 = acc[m][3];
        fn(wr * 128 + m * 16 + fr, wc * 64 + fq * 16, v);
        __builtin_amdgcn_sched_barrier(0);
    }
}
template <class F> DEV void epi_rows10(const f32x4 (&acc)[10][4], F fn) {
    const int lane = TIDX & 63, wid = TIDX >> 6, wr = wid >> 1, wc = wid & 1, fr = lane & 15, fq = lane >> 4;
#pragma unroll
    for (int m = 0; m < 10; ++m) {
        Row16 v; v.a0 = acc[m][0]; v.a1 = acc[m][1]; v.a2 = acc[m][2]; v.a3 = acc[m][3];
        fn(wr * 160 + m * 16 + fr, wc * 64 + fq * 16, v);
        __builtin_amdgcn_sched_barrier(0);
    }
}
DEV void st16_bf16(bf16_t* d, const Row16& v) {
    u32x4 a, b;
    a.x = pack2(v.a0[0], v.a0[1]); a.y = pack2(v.a0[2], v.a0[3]); a.z = pack2(v.a1[0], v.a1[1]); a.w = pack2(v.a1[2], v.a1[3]);
    b.x = pack2(v.a2[0], v.a2[1]); b.y = pack2(v.a2[2], v.a2[3]); b.z = pack2(v.a3[0], v.a3[1]); b.w = pack2(v.a3[2], v.a3[3]);
    *(u32x4*)d = a; *(u32x4*)(d + 8) = b;
}
DEV void st16_f32(float* d, const Row16& v) { *(f32x4*)d = v.a0; *(f32x4*)(d + 4) = v.a1; *(f32x4*)(d + 8) = v.a2; *(f32x4*)(d + 12) = v.a3; }
DEV void st16_bf16(bf16_t* d, const float* v) {
    u32x4 a, b;
    a.x = pack2(v[0], v[1]); a.y = pack2(v[2], v[3]); a.z = pack2(v[4], v[5]); a.w = pack2(v[6], v[7]);
    b.x = pack2(v[8], v[9]); b.y = pack2(v[10], v[11]); b.z = pack2(v[12], v[13]); b.w = pack2(v[14], v[15]);
    *(u32x4*)d = a; *(u32x4*)(d + 8) = b;
}
DEV void st8_bf16(bf16_t* d, const float* v) {
    u32x4 a; a.x = pack2(v[0], v[1]); a.y = pack2(v[2], v[3]); a.z = pack2(v[4], v[5]); a.w = pack2(v[6], v[7]);
    *(u32x4*)d = a;
}
DEV void st16_f32(float* d, const float* v) {
#pragma unroll
    for (int q = 0; q < 4; ++q) *(f32x4*)(d + 4 * q) = (f32x4){v[4 * q], v[4 * q + 1], v[4 * q + 2], v[4 * q + 3]};
}
DEV void ld16_f32(const float* s, float* v) {
#pragma unroll
    for (int q = 0; q < 4; ++q) { const f32x4 t = *(const f32x4*)(s + 4 * q); v[4 * q] = t[0]; v[4 * q + 1] = t[1]; v[4 * q + 2] = t[2]; v[4 * q + 3] = t[3]; }
}
DEV void ld16_bf16(const bf16_t* s, float* v) {
    const bf16x8 a = *(const bf16x8*)s, b = *(const bf16x8*)(s + 8);
#pragma unroll
    for (int q = 0; q < 8; ++q) { v[q] = bf2f((bf16_t)a[q]); v[8 + q] = bf2f((bf16_t)b[q]); }
}
DEV float sum_fq(float s) { s += __shfl_xor(s, 16); s += __shfl_xor(s, 32); return s; }

DEV void up_row_map(int nt, int R, int& mat, int& j) { const int wc = R >> 6, n = (R >> 4) & 3, fq = (R >> 2) & 3, reg = R & 3; mat = n >> 1; j = nt * 64 + wc * 32 + fq * 8 + (n & 1) * 4 + reg; }
DEV int win_src_col(int nd) { if (nd < 3072) return nd; if (nd < 3584) return nd + 16; if (nd < 3600) return nd - 512; return -1; }

template <class F> DEV void transpose_tile(char* smem, F srcfn, bf16_t* dst, int ldd, int k0, int nd0, bool pk = false) {
    float* t = (float*)smem;
    const int tid = TIDX, a = tid & 63, q = tid >> 6;
#pragma unroll 4
    for (int i = 0; i < 16; ++i) { const int k = q + 4 * i; t[k * 65 + a] = srcfn(k0 + k, nd0 + a); }
    __syncthreads();
#pragma unroll 4
    for (int i = 0; i < 16; ++i) { const int nl = q + 4 * i; const long o = pk ? pkl(nd0 + nl, k0 + a, ldd >> 5) : (long)(nd0 + nl) * ldd + k0 + a; dst[o] = f2bf(t[a * 65 + nl]); }
    __syncthreads();
}
DEV void s5_disc(CParams& p, int g, int n, float& lr, float& rev, float& f_re, float& f_im) {
    const float dt = __expf(p.s5_log_dt[g]);
    const float lre = fminf(p.s5_a_re[g * 64 + n], -1e-4f), lim = p.s5_a_im[g * 64 + n];
    lr = lre * dt; rev = lim * dt * 0.15915494309189535f;
    const float mag = __expf(lr), fr_ = __builtin_amdgcn_fractf(rev);
    const float ab_re = mag * __builtin_amdgcn_cosf(fr_), ab_im = mag * __builtin_amdgcn_sinf(fr_);
    const float den = lre * lre + lim * lim, num_re = ab_re - 1.f;
    f_re = (num_re * lre + ab_im * lim) / den; f_im = (ab_im * lre - num_re * lim) / den;
}
DEV void cpow(float lr, float rev, float tau, float& re, float& im) {
    const float mag = __expf(lr * tau), fr_ = __builtin_amdgcn_fractf(rev * tau);
    re = mag * __builtin_amdgcn_cosf(fr_); im = mag * __builtin_amdgcn_sinf(fr_);
}

constexpr int P0_MOD = 192, P0_WIN = 16 * 58, P0_WOUT = 24 * 16, P0_WGLU = 64, P0_WR = 64, P0_WSUP = 128, P0_WS2 = 64, P0_KERN = 1024, P0_W5S = 1024, P0_E5 = 1024, P0_ZERO = 16;
constexpr int P0_TASKS = P0_MOD + P0_WIN + P0_WOUT + P0_WGLU + P0_WR + P0_WSUP + P0_WS2 + P0_KERN + P0_W5S + P0_E5 + P0_ZERO;

DEV void phase0(CParams& p, int task, char* smem, unsigned* modcnt) {
    const int tid = TIDX;
    if (task < P0_MOD) {
        const int c4 = tid & 7, kq = tid >> 3, n0 = task * 32 + c4 * 4;
        f32x4 a0 = {0.f, 0.f, 0.f, 0.f}, a1 = {0.f, 0.f, 0.f, 0.f};
        for (int k0 = kq; k0 < 1024; k0 += 256) {
            f32x4 w[8]; float c0[8], c1[8];
#pragma unroll
            for (int u = 0; u < 8; ++u) { const int k = k0 + 32 * u; w[u] = *(const f32x4*)(p.w_ada + (long)k * 6144 + n0); c0[u] = p.c[k]; c1[u] = p.c[1024 + k]; }
#pragma unroll
            for (int u = 0; u < 8; ++u) { a0 += siluf_(c0[u]) * w[u]; a1 += siluf_(c1[u]) * w[u]; }
        }
        float* red = (float*)smem;
        *(f32x4*)(red + (kq * 8 + c4) * 8) = a0; *(f32x4*)(red + (kq * 8 + c4) * 8 + 4) = a1;
        __syncthreads();
        if (tid < 64) {
            const int b = tid >> 5, col = tid & 31, c4o = col >> 2, e = col & 3;
            float s = 0.f;
            for (int q = 0; q < 32; ++q) s += red[(q * 8 + c4o) * 8 + b * 4 + e];
            p.MOD[b * 6144 + task * 32 + col] = s + p.b_ada[task * 32 + col];
        }
        asm volatile("s_waitcnt vmcnt(0)" ::: "memory");
        __syncthreads();
        if (tid == 0) {
            __builtin_amdgcn_fence(__ATOMIC_RELEASE, "agent");
            asm volatile("s_waitcnt vmcnt(0)" ::: "memory");
            __hip_atomic_fetch_add(modcnt, 1u, __ATOMIC_RELAXED, __HIP_MEMORY_SCOPE_AGENT);
        }
        return;
    }
    task -= P0_MOD;
    if (task < P0_WIN) {
        const int kt = task / 58, nt = task % 58;
        transpose_tile(smem, [&](int k, int nd) __attribute__((always_inline)) { const int sc = win_src_col(nd); return sc < 0 ? 0.f : p.w_in[(long)k * NPROJ + sc]; }, p.WINT, 1024, kt * 64, nt * 64, true);
        return;
    }
    task -= P0_WIN;
    if (task < P0_WOUT) {
        const int kt = task / 16, nt = task % 16;
        transpose_tile(smem, [&](int k, int nd) __attribute__((always_inline)) { const float g = (k < 1024) ? p.ssd_norm_gain[k] : p.s5_norm_gain[k - 1024]; return g * p.w_out[(long)k * 1024 + nd]; }, p.WOUTT, 1536, kt * 64, nt * 64, true);
        return;
    }
    task -= P0_WOUT;
    if (task < P0_WGLU) {
        const int kt = task / 8, nt = task % 8;
        transpose_tile(smem, [&](int k, int nd) __attribute__((always_inline)) { return p.w_glu[(long)k * 512 + nd]; }, p.WGLUT, 512, kt * 64, nt * 64, true);
        return;
    }
    task -= P0_WGLU;
    if (task < P0_WR) {
        const int kt = task / 4, nt = task % 4;
        transpose_tile(smem, [&](int k, int nd) __attribute__((always_inline)) { return p.w_router[(long)k * 256 + nd]; }, p.WRT, 1024, kt * 64, nt * 64, true);
        return;
    }
    task -= P0_WR;
    if (task < P0_WSUP) {
        const int kt = task / 8, nt = task % 8;
        transpose_tile(smem, [&](int k, int nd) __attribute__((always_inline)) { int mat, j; up_row_map(nd >> 7, nd & 127, mat, j); return (mat ? p.ws3 : p.ws1)[(long)k * 256 + j]; }, p.WSUPT, 1024, kt * 64, nt * 64, true);
        return;
    }
    task -= P0_WSUP;
    if (task < P0_WS2) {
        const int kt = task / 16, nt = task % 16;
        transpose_tile(smem, [&](int k, int nd) __attribute__((always_inline)) { return p.ws2[(long)k * 1024 + nd]; }, p.WS2T, 256, kt * 64, nt * 64, true);
        return;
    }
    task -= P0_WS2;
    float* sG = (float*)smem;
    if (task < P0_KERN) {
        const int g = task >> 5, tau = task & 31;
        if (tid < 64) {
            float lr, rev, fre, fim, pr, pi; s5_disc(p, g, tid, lr, rev, fre, fim); cpow(lr, rev, (float)tau, pr, pi);
            sG[tid * 2] = pr * fre - pi * fim; sG[tid * 2 + 1] = pr * fim + pi * fre;
        }
        __syncthreads();
        const int pp = tid >> 4, q = tid & 15;
        float s = 0.f;
        for (int n = 0; n < 64; ++n) {
            const float cr = p.s5_c_re[(g * 16 + pp) * 64 + n], ci = p.s5_c_im[(g * 16 + pp) * 64 + n];
            const float gr = sG[n * 2], gi = sG[n * 2 + 1];
            const float xr = cr * gr - ci * gi, xi = cr * gi + ci * gr;
            const float br = p.s5_b_re[(g * 64 + n) * 16 + q], bi = p.s5_b_im[(g * 64 + n) * 16 + q];
            s += xr * br - xi * bi;
        }
        p.KERN[(long)(g * 32 + tau) * 256 + tid] = s;
        __syncthreads();
        return;
    }
    task -= P0_KERN;
    if (task < P0_W5S) {
        const int g = task >> 5, tp = task & 31;
        if (tid < 64) { float lr, rev, fre, fim, pr, pi; s5_disc(p, g, tid, lr, rev, fre, fim); cpow(lr, rev, (float)(tp + 1), pr, pi); sG[tid * 2] = pr; sG[tid * 2 + 1] = pi; }
        __syncthreads();
#pragma unroll
        for (int i = 0; i < 8; ++i) {
            const int idx = tid + 256 * i, pp = idx >> 7, m = idx & 127, n = m & 63;
            const float cr = p.s5_c_re[(g * 16 + pp) * 64 + n], ci = p.s5_c_im[(g * 16 + pp) * 64 + n];
            const float gr = sG[n * 2], gi = sG[n * 2 + 1];
            const float v = (m < 64) ? (cr * gr - ci * gi) : -(cr * gi + ci * gr);
            p.W5T[(long)g * 512 * 640 + pkl(tp * 16 + pp, 512 + m, 20)] = f2bf(v);
        }
        __syncthreads();
        return;
    }
    task -= P0_W5S;
    if (task < P0_E5) {
        const int g = task >> 5, jp = task & 31;
        if (tid < 64) {
            float lr, rev, fre, fim, pr, pi; s5_disc(p, g, tid, lr, rev, fre, fim); cpow(lr, rev, (float)(S5Q - 1 - jp), pr, pi);
            sG[tid * 2] = pr * fre - pi * fim; sG[tid * 2 + 1] = pr * fim + pi * fre;
            if (jp == 0) { float qr, qi; cpow(lr, rev, (float)S5Q, qr, qi); p.AQ[(g * 64 + tid) * 2] = qr; p.AQ[(g * 64 + tid) * 2 + 1] = qi; }
        }
        __syncthreads();
#pragma unroll
        for (int i = 0; i < 8; ++i) {
            const int idx = tid + 256 * i, m = idx >> 4, q = idx & 15, n = m & 63;
            const float gr = sG[n * 2], gi = sG[n * 2 + 1];
            const float br = p.s5_b_re[(g * 64 + n) * 16 + q], bi = p.s5_b_im[(g * 64 + n) * 16 + q];
            const float v = (m < 64) ? (gr * br - gi * bi) : (gr * bi + gi * br);
            p.E5T[(long)g * 128 * 512 + pkl(m, jp * 16 + q, 16)] = f2bf(v);
        }
        __syncthreads();
        return;
    }
    task -= P0_E5;
    {
        if (task == 0) p.CNT[tid] = 0;
    }
}

DEV void modnorm_row(const float* src, int row, const float* gain, const float* sc, const float* sh, const float* ssq, bf16_t* dst, unsigned char* dst8 = nullptr) {
    const int lane = TIDX & 63;
    const float* xr = src + (long)row * 1024;
    f32x4 v[4];
#pragma unroll
    for (int i = 0; i < 4; ++i) v[i] = *(const f32x4*)(xr + lane * 4 + 256 * i);
    float ss;
    if (ssq) { ss = 0.f;
#pragma unroll
        for (int q = 0; q < 16; ++q) ss += ssq[(long)row * 16 + q]; }
    else {
        ss = 0.f;
#pragma unroll
        for (int i = 0; i < 4; ++i) ss += v[i][0] * v[i][0] + v[i][1] * v[i][1] + v[i][2] * v[i][2] + v[i][3] * v[i][3];
        ss = wave_sum(ss);
    }
    const float rstd = rsqrtf(ss * (1.f / 1024.f) + 1e-6f);
#pragma unroll
    for (int i = 0; i < 4; ++i) {
        const int c = lane * 4 + 256 * i;
        const f32x4 g = *(const f32x4*)(gain + c), s1 = *(const f32x4*)(sc + c), s0 = *(const f32x4*)(sh + c);
        float o[4];
#pragma unroll
        for (int e = 0; e < 4; ++e) o[e] = v[i][e] * rstd * g[e] * (1.f + s1[e]) + s0[e];
        u32x2 w; w.x = pack2(o[0], o[1]); w.y = pack2(o[2], o[3]);
        *(u32x2*)(dst + pkl(row, c, 32)) = w;
        if (dst8) *(unsigned*)(dst8 + (long)row * 1024 + c) = pack4_fp8(o[0], o[1], o[2], o[3]);
    }
}
constexpr int P0B_ROWS = T_TOK / 4, P0B_TOEP = 1024;
DEV void phase0b_rows(CParams& p, int task) {
    const int row = task * 4 + (TIDX >> 6), b = row >> 13;
    modnorm_row(p.x, row, p.norm1_gain, p.MOD + b * 6144 + 1024, p.MOD + b * 6144, nullptr, p.H);
}
DEV void phase0b_toep(CParams& p, int task) {
    const int g = task >> 5, tp = task & 31;
#pragma unroll
    for (int i = 0; i < 4; ++i) {
        const int idx = TIDX + 256 * i, pp = idx >> 6, kc8 = (idx & 63) * 8, jp = kc8 >> 4, q0 = kc8 & 15;
        float v[8];
        if (jp <= tp) {
            const float* s = p.KERN + (long)(g * 32 + (tp - jp)) * 256 + pp * 16 + q0;
            const f32x4 a = *(const f32x4*)s, b4 = *(const f32x4*)(s + 4);
#pragma unroll
            for (int q = 0; q < 4; ++q) { v[q] = a[q]; v[4 + q] = b4[q]; }
        } else {
#pragma unroll
            for (int q = 0; q < 8; ++q) v[q] = 0.f;
        }
        st8_bf16(p.W5T + (long)g * 512 * 640 + pkl(tp * 16 + pp, kc8, 20), v);
    }
}

DEV bool xcd_tile(int idx, int MT, int NT, int& mt, int& nt) {
    const int x = blockIdx.x & 7, member = blockIdx.x >> 3, nmem = (gridDim.x - x + 7) >> 3;
    const int per = MT >> 3, j = member + idx * nmem;
    if (j >= per * NT) return false;
    mt = x * per + j % per; nt = j / per; return true;
}

constexpr int Q_SLOTS = 8, Q_WORDS = Q_SLOTS * 2 * 8 * 16;
DEV unsigned* q_head(CParams& p, int slot, bool rep, int group) { return p.bar + XCD_BAR_WORDS + ((slot * 2 + (rep ? 1 : 0)) * 8 + group) * 16; }
DEV int dq_next(unsigned* q, char* smem) {
    volatile LAS unsigned* w = (volatile LAS unsigned*)(smem + SMEM_BYTES - 32);
    __syncthreads();
    if (TIDX == 0) *w = __hip_atomic_fetch_add(q, 1u, __ATOMIC_RELAXED, __HIP_MEMORY_SCOPE_AGENT);
    __syncthreads();
    return (int)*w;
}

constexpr int P1_TASKS = 64 * 29;
DEV void phase1(CParams& p, int mt, int nt, char* smem, bool rep = false) {
    GRow<4> al; al.initp(p.H, 32, (long)mt * 256, false);
    GRow<2> bl; bl.initp(p.WINT, 32, (long)nt * 128, true);
    f32x4 acc[8][4]; zero_acc(acc);
    gemm_loop<true>(smem, al, bl, 32, acc, rep);
    epi_rows(acc, [&](int r, int c0, const Row16& v) __attribute__((always_inline)) {
        const long t = (long)mt * 256 + r;
        if (rep) { st16_bf16(p.OUTR + t * 4096 + nt * 128 + c0, v); return; }
        if (nt < 8) st16_bf16(p.Z + t * 1024 + nt * 128 + c0, v);
        else if (nt < 24) st16_bf16(p.XBCR + t * 2048 + (nt - 8) * 128 + c0, v);
        else if (nt < 28) { const int g = ((nt - 24) * 128 + c0) >> 4; st16_bf16(p.UG + (long)g * T_TOK * 16 + pkl(t >> 5, (int)(t & 31) * 16, 16), v); }
        else if (c0 == 0) st16_f32(p.DTR + t * 16, v);
    });
}

constexpr int P2_CONV = 2048, P2_E = 64, P2_TASKS = P2_CONV + P2_E;
DEV void phase2(CParams& p, int task, char* smem) {
    const int tid = TIDX;
    if (task < P2_CONV) {
        const int b = task >> 10, c = (task >> 5) & 31, cb = task & 31;
        float* sT = (float*)smem;
        float* sdt = sT + 64 * 257;
        float* sdec = sdt + 256;
        float* sscan = sdec + 256;
        const bool isx = cb < 16;
        if (isx) {
            const int h = cb;
            const float raw = p.DTR[((long)b * SEQ + c * 256 + tid) * 16 + h] + p.dt_bias[h];
            const float dtv = raw > 20.f ? raw : log1pf(__expf(raw));
            const float a = -__expf(p.ssd_a_log[h]);
            sscan[tid] = dtv * a;
            __syncthreads();
            for (int off = 1; off < 256; off <<= 1) {
                const float v = (tid >= off) ? sscan[tid - off] : 0.f;
                __syncthreads();
                sscan[tid] += v;
                __syncthreads();
            }
            const float acs = sscan[tid], aend = sscan[255];
            p.ACS[((long)b * 16 + h) * SEQ + c * 256 + tid] = acs;
            sdt[tid] = dtv; sdec[tid] = dtv * __expf(aend - acs);
        }
        __syncthreads();
        {
            const int cg = tid & 7, tg = tid >> 3, gch0 = cb * 64 + cg * 8, t0 = c * 256 + tg * 8;
            float w[4][8], bias[8];
#pragma unroll
            for (int k = 0; k < 4; ++k) { const f32x4 a = *(const f32x4*)(p.conv_w + k * 2048 + gch0), b4 = *(const f32x4*)(p.conv_w + k * 2048 + gch0 + 4);
#pragma unroll
                for (int q = 0; q < 4; ++q) { w[k][q] = a[q]; w[k][4 + q] = b4[q]; } }
            { const f32x4 a = *(const f32x4*)(p.conv_b + gch0), b4 = *(const f32x4*)(p.conv_b + gch0 + 4);
#pragma unroll
              for (int q = 0; q < 4; ++q) { bias[q] = a[q]; bias[4 + q] = b4[q]; } }
            const bf16_t* rawp = p.XBCR + (long)b * SEQ * 2048 + gch0;
            bf16x8 rows[11];
#pragma unroll
            for (int i = 0; i < 11; ++i) { const int t = t0 - 3 + i; rows[i] = (t >= 0) ? *(const bf16x8*)(rawp + (long)t * 2048) : (bf16x8){0, 0, 0, 0, 0, 0, 0, 0}; }
            float v[8][8];
#pragma unroll
            for (int i = 0; i < 8; ++i)
#pragma unroll
                for (int q = 0; q < 8; ++q) {
                    float s = bias[q];
#pragma unroll
                    for (int k = 0; k < 4; ++k) s += w[k][q] * bf2f((bf16_t)rows[i + k][q]);
                    v[i][q] = siluf_(s);
                }
            bf16_t* natp; long nld;
            if (cb < 16) { natp = p.XN + gch0; nld = 1024; } else if (cb < 24) { natp = p.BN + (gch0 - 1024); nld = 512; } else { natp = p.CN + (gch0 - 1536); nld = 512; }
#pragma unroll
            for (int i = 0; i < 8; ++i) st8_bf16(natp + ((long)b * SEQ + t0 + i) * nld, v[i]);
            if (isx) {
                float dtv[8], dcv[8];
#pragma unroll
                for (int i = 0; i < 8; ++i) { dtv[i] = sdt[tg * 8 + i]; dcv[i] = sdec[tg * 8 + i]; }
#pragma unroll
                for (int q = 0; q < 8; ++q) {
                    float a[8], d[8];
#pragma unroll
                    for (int i = 0; i < 8; ++i) { a[i] = v[i][q] * dtv[i]; d[i] = v[i][q] * dcv[i]; }
                    const long o = (((long)b * 16 + cb) * 64 + cg * 8 + q) * SEQ + t0;
                    st8_bf16(p.XDTT + o, a); st8_bf16(p.XDECT + pkl(((long)b * 16 + cb) * 64 + cg * 8 + q, t0, 256), d);
                }
            } else if (cb < 24) {
                const int g = (cb - 16) >> 1, half = (cb - 16) & 1;
#pragma unroll
                for (int q = 0; q < 8; ++q) {
                    float a[8];
#pragma unroll
                    for (int i = 0; i < 8; ++i) a[i] = v[i][q];
                    st8_bf16(p.BT + pkl(((long)b * 4 + g) * 128 + half * 64 + cg * 8 + q, t0, 256), a);
                }
            }
        }
        __syncthreads();
        return;
    }
}
DEV void phase2e5(CParams& p, int task, char* smem) {
    {
        const int g = task >> 1, mt = task & 1;
        GRow<4> al; al.initp(p.UG + (long)g * T_TOK * 16, 16, (long)mt * 256, false);
        GRow<2> bl; bl.initp(p.E5T + (long)g * 128 * 512, 16, 0, true);
        f32x4 acc[8][4]; zero_acc(acc);
        gemm_loop<true>(smem, al, bl, 16, acc);
        epi_rows(acc, [&](int r, int c0, const Row16& v) __attribute__((always_inline)) { st16_f32(p.E5 + ((long)g * 512 + mt * 256 + r) * 128 + c0, v); });
    }
}

constexpr int P3_ST = 256, P3_CARRY = 256, P3_TASKS = P3_ST + P3_CARRY;
DEV void phase3(CParams& p, int task, char* smem) {
    const int tid = TIDX;
    if (task < P3_ST) {
        const int g = task & 3, c = (task >> 2) & 31, b = task >> 7;
        GRow<4> al; al.initp(p.XDECT, 256, ((long)b * 16 + 4 * g) * 64, false, c * 8);
        GRow<2> bl; bl.initp(p.BT, 256, ((long)b * 4 + g) * 128, true, c * 8);
        f32x4 acc[8][4]; zero_acc(acc);
        gemm_loop<true>(smem, al, bl, 8, acc);
        float* dst = p.ST + ((((long)b * 32 + c) * 16 + 4 * g) * 64) * 128;
        epi_rows(acc, [&](int r, int c0, const Row16& v) __attribute__((always_inline)) { st16_f32(dst + (long)r * 128 + c0, v); });
        return;
    }
    task -= P3_ST;
    {
        const int nq = task & 3, g = (task >> 2) & 31, b = task >> 7;
        const int n = nq * 16 + (tid & 15), seg = tid >> 4;
        const float qr = p.AQ[(g * 64 + n) * 2], qi = p.AQ[(g * 64 + n) * 2 + 1];
        const float* e = p.E5 + ((long)g * 512 + b * 256 + seg * 16) * 128;
        float er[16], ei[16];
#pragma unroll
        for (int u = 0; u < 16; ++u) { er[u] = e[(long)u * 128 + n]; ei[u] = e[(long)u * 128 + 64 + n]; }
        float tr = 0.f, ti = 0.f;
#pragma unroll
        for (int u = 0; u < 16; ++u) {
            const float lr = tr, li = ti;
            const float nr = qr * tr - qi * ti + er[u], ni = qr * ti + qi * tr + ei[u];
            tr = nr; ti = ni; er[u] = lr; ei[u] = li;
        }
        float pr = qr, pi = qi;
#pragma unroll
        for (int s = 0; s < 4; ++s) { const float a = pr * pr - pi * pi, c2 = 2.f * pr * pi; pr = a; pi = c2; }
        float* sx = (float*)smem;
        sx[(seg * 16 + (tid & 15)) * 2] = tr; sx[(seg * 16 + (tid & 15)) * 2 + 1] = ti;
        __syncthreads();
        if (tid < 16) {
            float sr = 0.f, si = 0.f;
            for (int s = 0; s < 16; ++s) {
                const float t0 = sx[(s * 16 + tid) * 2], t1 = sx[(s * 16 + tid) * 2 + 1];
                sx[(s * 16 + tid) * 2] = sr; sx[(s * 16 + tid) * 2 + 1] = si;
                const float nr = pr * sr - pi * si + t0, ni = pr * si + pi * sr + t1;
                sr = nr; si = ni;
            }
        }
        __syncthreads();
        float sr = sx[(seg * 16 + (tid & 15)) * 2], si = sx[(seg * 16 + (tid & 15)) * 2 + 1];
        bf16_t* o = p.SPREV + (long)g * 512 * 128;
#pragma unroll
        for (int u = 0; u < 16; ++u) {
            const int row = b * 256 + seg * 16 + u;
            o[pkl(row, n, 4)] = f2bf(sr + er[u]); o[pkl(row, 64 + n, 4)] = f2bf(si + ei[u]);
            const float nr = qr * sr - qi * si, ni = qr * si + qi * sr;
            sr = nr; si = ni;
        }
        __syncthreads();
    }
}

constexpr int P4_SCAN = 256, P4_Y = 256, P4_TASKS = P4_SCAN + P4_Y;
DEV void phase4(CParams& p, int task, char* smem) {
    const int tid = TIDX;
    if (task < P4_SCAN) {
        const int id = task * 256 + tid, pn = (id & 2047) * 4, h = (id >> 11) & 15, b = id >> 15;
        f32x4 s = {0.f, 0.f, 0.f, 0.f};
        for (int c0 = 0; c0 < 32; c0 += 8) {
            f32x4 st[8]; float at[8];
#pragma unroll
            for (int u = 0; u < 8; ++u) {
                st[u] = *(const f32x4*)(p.ST + ((((long)b * 32 + c0 + u) * 16 + h) * 8192) + pn);
                at[u] = p.ACS[((long)b * 16 + h) * SEQ + (c0 + u) * 256 + 255];
            }
#pragma unroll
            for (int u = 0; u < 8; ++u) {
                u32x2 w; w.x = pack2(s[0], s[1]); w.y = pack2(s[2], s[3]);
                *(u32x2*)(p.PREV + ((((long)b * 32 + c0 + u) * 16 + h) * 8192) + pn) = w;
                s = __expf(at[u]) * s + st[u];
            }
        }
        return;
    }
    task -= P4_SCAN;
    {
        const int nt = task & 3, mt = (task >> 2) & 1, g = task >> 3;
        f32x4 acc[8][4]; zero_acc(acc);
        {
            GRow<4> al; al.initp(p.UG + (long)g * T_TOK * 16, 16, (long)mt * 256, false);
            GRow<2> bl; bl.initp(p.W5T + (long)g * 512 * 640, 20, (long)nt * 128, true);
            gemm_loop<true>(smem, al, bl, 4 * (nt + 1), acc);
        }
        {
            GRow<4> al; al.initp(p.SPREV + (long)g * 512 * 128, 4, (long)mt * 256, false);
            GRow<2> bl; bl.initp(p.W5T + (long)g * 512 * 640, 20, (long)nt * 128, true, 16);
            gemm_loop<true>(smem, al, bl, 4, acc);
        }
        epi_rows(acc, [&](int r, int c0, const Row16& v) __attribute__((always_inline)) {
            const int rr = mt * 256 + r, tp = (nt * 128 + c0) >> 4;
            const long t = (long)rr * 32 + tp;
            float u[16], d[16], o[16];
            ld16_bf16(p.UG + (long)g * T_TOK * 16 + pkl(t >> 5, (int)(t & 31) * 16, 16), u);
            ld16_f32(p.s5_d + g * 16, d);
#pragma unroll
            for (int q = 0; q < 16; ++q) o[q] = gelu_tanh(v.get(q) + d[q] * u[q]);
            st16_bf16(p.G5 + pkl(t, g * 16, 16), o);
        });
    }
}

constexpr int P5_SSD = 2048;
DEV void phase5(CParams& p, int task, char* smem) {
    const int tid = TIDX, lane = tid & 63, wid = tid >> 6, fr = lane & 15, fq = lane >> 4;
    if (task < P5_SSD) {
        const int half = task & 1, h = (task >> 1) & 15, c = (task >> 5) & 31, b = task >> 10, g = h >> 2;
        const int l0 = half * 128 + wid * 32;
        const long tok0 = (long)b * SEQ + c * 256;
        char* sB = smem;
        char* sX = smem + 17408;
        char* sM = smem + 17408 + 9216 + wid * 4608;
        float* sacs = (float*)(smem + 17408 + 9216 + 18432);
        sacs[tid] = p.ACS[((long)b * 16 + h) * SEQ + c * 256 + tid];
        bf16x8 cf[2][4];
#pragma unroll
        for (int mi = 0; mi < 2; ++mi)
#pragma unroll
            for (int ks = 0; ks < 4; ++ks) cf[mi][ks] = *(const bf16x8*)(p.CN + (tok0 + l0 + mi * 16 + fr) * 512 + g * 128 + ks * 32 + fq * 8);
        {
            const bf16_t* pv = p.PREV + ((((long)b * 32 + c) * 16 + h) * 64) * 128;
#pragma unroll
            for (int i = 0; i < 4; ++i) { const int q = tid + 256 * i, r = q >> 4, kc = q & 15; *(bf16x8*)(sB + r * 272 + kc * 16) = *(const bf16x8*)(pv + r * 128 + kc * 8); }
        }
        __syncthreads();
        f32x4 y[2][4];
#pragma unroll
        for (int mi = 0; mi < 2; ++mi)
#pragma unroll
            for (int np = 0; np < 4; ++np) y[mi][np] = (f32x4){0.f, 0.f, 0.f, 0.f};
#pragma unroll
        for (int ks = 0; ks < 4; ++ks)
#pragma unroll
            for (int np = 0; np < 4; ++np) {
                const bf16x8 pf = *(const bf16x8*)(sB + (np * 16 + fr) * 272 + ks * 64 + fq * 16);
#pragma unroll
                for (int mi = 0; mi < 2; ++mi) y[mi][np] = __builtin_amdgcn_mfma_f32_16x16x32_bf16(pf, cf[mi][ks], y[mi][np], 0, 0, 0);
            }
        float al[2];
#pragma unroll
        for (int mi = 0; mi < 2; ++mi) {
            al[mi] = sacs[l0 + mi * 16 + fr];
            const float e = __expf(al[mi]);
#pragma unroll
            for (int np = 0; np < 4; ++np) y[mi][np] *= e;
        }
        __syncthreads();
        const int nj = half * 2 + 2;
        bf16x8 rbB[4], rbX[2];
#pragma unroll
        for (int i = 0; i < 4; ++i) { const int q = tid + 256 * i, r = q >> 4, kc = q & 15; rbB[i] = *(const bf16x8*)(p.BN + (tok0 + r) * 512 + g * 128 + kc * 8); }
#pragma unroll
        for (int i = 0; i < 2; ++i) { const int q = tid + 256 * i, r = q >> 3, kc = q & 7; rbX[i] = *(const bf16x8*)(p.XDTT + (((long)b * 16 + h) * 64 + r) * SEQ + c * 256 + kc * 8); }
        for (int jb = 0; jb < nj; ++jb) {
#pragma unroll
            for (int i = 0; i < 4; ++i) { const int q = tid + 256 * i, r = q >> 4, kc = q & 15; *(bf16x8*)(sB + r * 272 + kc * 16) = rbB[i]; }
#pragma unroll
            for (int i = 0; i < 2; ++i) { const int q = tid + 256 * i, r = q >> 3, kc = q & 7; *(bf16x8*)(sX + r * 144 + kc * 16) = rbX[i]; }
            __syncthreads();
            if (jb + 1 < nj) {
#pragma unroll
                for (int i = 0; i < 4; ++i) { const int q = tid + 256 * i, r = q >> 4, kc = q & 15; rbB[i] = *(const bf16x8*)(p.BN + (tok0 + (jb + 1) * 64 + r) * 512 + g * 128 + kc * 8); }
#pragma unroll
                for (int i = 0; i < 2; ++i) { const int q = tid + 256 * i, r = q >> 3, kc = q & 7; rbX[i] = *(const bf16x8*)(p.XDTT + (((long)b * 16 + h) * 64 + r) * SEQ + c * 256 + (jb + 1) * 64 + kc * 8); }
            }
            if (jb * 64 <= l0 + 31) {
#pragma unroll
                for (int nh = 0; nh < 2; ++nh) {
                    f32x4 S[2][2];
#pragma unroll
                    for (int mi = 0; mi < 2; ++mi)
#pragma unroll
                        for (int n2 = 0; n2 < 2; ++n2) S[mi][n2] = (f32x4){0.f, 0.f, 0.f, 0.f};
#pragma unroll
                    for (int ks = 0; ks < 4; ++ks)
#pragma unroll
                        for (int n2 = 0; n2 < 2; ++n2) {
                            const bf16x8 bf = *(const bf16x8*)(sB + ((nh * 2 + n2) * 16 + fr) * 272 + ks * 64 + fq * 16);
#pragma unroll
                            for (int mi = 0; mi < 2; ++mi) S[mi][n2] = __builtin_amdgcn_mfma_f32_16x16x32_bf16(bf, cf[mi][ks], S[mi][n2], 0, 0, 0);
                        }
#pragma unroll
                    for (int n2 = 0; n2 < 2; ++n2) {
                        const int n = nh * 2 + n2, s0 = jb * 64 + n * 16 + fq * 4;
                        const f32x4 as4 = *(const f32x4*)(sacs + s0);
#pragma unroll
                        for (int mi = 0; mi < 2; ++mi) {
                            const int l = l0 + mi * 16 + fr;
                            float v[4];
#pragma unroll
                            for (int j = 0; j < 4; ++j) v[j] = (s0 + j <= l) ? S[mi][n2][j] * __expf(al[mi] - as4[j]) : 0.f;
                            u32x2 w; w.x = pack2(v[0], v[1]); w.y = pack2(v[2], v[3]);
                            *(u32x2*)(sM + (mi * 16 + fr) * 144 + (n * 16 + fq * 4) * 2) = w;
                        }
                    }
                }
                asm volatile("s_waitcnt lgkmcnt(0)" ::: "memory");
#pragma unroll
                for (int ks = 0; ks < 2; ++ks) {
                    bf16x8 mf[2];
#pragma unroll
                    for (int mi = 0; mi < 2; ++mi) mf[mi] = *(const bf16x8*)(sM + (mi * 16 + fr) * 144 + ks * 64 + fq * 16);
#pragma unroll
                    for (int np = 0; np < 4; ++np) {
                        const bf16x8 xf = *(const bf16x8*)(sX + (np * 16 + fr) * 144 + ks * 64 + fq * 16);
#pragma unroll
                        for (int mi = 0; mi < 2; ++mi) y[mi][np] = __builtin_amdgcn_mfma_f32_16x16x32_bf16(xf, mf[mi], y[mi][np], 0, 0, 0);
                    }
                }
            }
            __syncthreads();
        }
        const float Dh = p.ssd_d[h];
#pragma unroll
        for (int mi = 0; mi < 2; ++mi) {
            const long t = tok0 + l0 + mi * 16 + fr;
            float ss = 0.f;
#pragma unroll
            for (int np = 0; np < 4; ++np) {
                const int col = h * 64 + np * 16 + fq * 4;
                const u32x2 xr = *(const u32x2*)(p.XN + t * 1024 + col), zr = *(const u32x2*)(p.Z + t * 1024 + col);
                float o[4];
#pragma unroll
                for (int j = 0; j < 4; ++j) {
                    const unsigned xw = (j < 2) ? xr.x : xr.y, zw = (j < 2) ? zr.x : zr.y;
                    const float xv = bf2f((bf16_t)((j & 1) ? (xw >> 16) : (xw & 0xffffu))), zv = bf2f((bf16_t)((j & 1) ? (zw >> 16) : (zw & 0xffffu)));
                    o[j] = (y[mi][np][j] + Dh * xv) * siluf_(zv);
                    ss += o[j] * o[j];
                }
                u32x2 w; w.x = pack2(o[0], o[1]); w.y = pack2(o[2], o[3]);
                *(u32x2*)(p.YG + pkl(t, col, 32)) = w;
            }
            ss = sum_fq(ss);
            if (fq == 0) p.SSQ[t * 16 + h] = ss;
        }
        return;
    }
}
DEV void phase5glu(CParams& p, int mt, int nt, char* smem) {
    {
        GRow<4> al; al.initp(p.G5, 16, (long)mt * 256, false);
        GRow<2> bl; bl.initp(p.WGLUT, 16, (long)nt * 128, true);
        f32x4 acc[8][4]; zero_acc(acc);
        gemm_loop(smem, al, bl, 16, acc);
        epi_rows(acc, [&](int r, int c0, const Row16& v) __attribute__((always_inline)) {
            const long t = (long)mt * 256 + r; const int col = nt * 128 + c0;
            float gv[16], bb[16], o[16];
            ld16_bf16(p.G5 + pkl(t, col, 16), gv);
            ld16_f32(p.b_glu + col, bb);
            float ss = 0.f;
#pragma unroll
            for (int q = 0; q < 16; ++q) { o[q] = gv[q] * sigmoidf_(v.get(q) + bb[q]); ss += o[q] * o[q]; }
            st16_bf16(p.Y5 + pkl(t, col, 16), o);
            ss = sum_fq(ss);
            if ((TIDX & 63) < 16) p.SSQ[(long)T_TOK * 16 + t * 8 + nt * 2 + (c0 >> 6)] = ss;
        });
    }
}

constexpr int P6_TASKS = 64 * 8;
DEV void phase6(CParams& p, int mt, int nt, char* smem) {
    float* srs = (float*)(smem + GEMM_SMEM);
    {
        const int r = TIDX; const long t = (long)mt * 256 + r;
        float s1 = 0.f, s2 = 0.f;
#pragma unroll
        for (int q = 0; q < 16; ++q) s1 += p.SSQ[t * 16 + q];
#pragma unroll
        for (int q = 0; q < 8; ++q) s2 += p.SSQ[(long)T_TOK * 16 + t * 8 + q];
        const float r1 = rsqrtf(s1 * (1.f / 1024.f) + 1e-6f), r2 = rsqrtf(s2 * (1.f / 512.f) + 1e-6f);
        srs[r] = r1 / r2; srs[256 + r] = r2;
    }
    __syncthreads();
    f32x4 acc[8][4]; zero_acc(acc);
    {
        GRow<4> al; al.initp(p.YG, 32, (long)mt * 256, false);
        GRow<2> bl; bl.initp(p.WOUTT, 48, (long)nt * 128, true);
        gemm_loop<true>(smem, al, bl, 32, acc);
    }
    {
        const int lane = TIDX & 63, wr = TIDX >> 7, fr = lane & 15;
#pragma unroll
        for (int m = 0; m < 8; ++m) {
            const float sc = srs[wr * 128 + m * 16 + fr];
#pragma unroll
            for (int n = 0; n < 4; ++n) acc[m][n] *= sc;
        }
    }
    {
        GRow<4> al; al.initp(p.Y5, 16, (long)mt * 256, false);
        GRow<2> bl; bl.initp(p.WOUTT, 48, (long)nt * 128, true, 32);
        gemm_loop<true>(smem, al, bl, 16, acc);
    }
    epi_rows(acc, [&](int r, int c0, const Row16& v) __attribute__((always_inline)) {
        const long t = (long)mt * 256 + r; const int col = nt * 128 + c0, b = (int)(t >> 13);
        const float r2 = srs[256 + r];
        float xv[16], gv[16], o[16];
        ld16_f32(p.x + t * 1024 + col, xv);
        ld16_f32(p.MOD + b * 6144 + 2048 + col, gv);
        float ss = 0.f;
#pragma unroll
        for (int q = 0; q < 16; ++q) { o[q] = xv[q] + gv[q] * (v.get(q) * r2); ss += o[q] * o[q]; }
        st16_f32(p.X1 + t * 1024 + col, o);
        ss = sum_fq(ss);
        if ((TIDX & 63) < 16) p.SSQ[(long)T_TOK * 24 + t * 16 + nt * 2 + (c0 >> 6)] = ss;
    });
    __syncthreads();
}

constexpr int P7_TASKS = T_TOK / 4;
DEV void phase7(CParams& p, int task) {
    const int row = task * 4 + (TIDX >> 6), b = row >> 13;
    modnorm_row(p.X1, row, p.norm2_gain, p.MOD + b * 6144 + 4096, p.MOD + b * 6144 + 3072, p.SSQ + (long)T_TOK * 24, p.H, p.H2F8);
}

constexpr int P8_R = 128, P8_S = 256, P8_TASKS = P8_R + P8_S;
DEV void phase8r(CParams& p, int mt, int nt, char* smem) {
    GRow<4> al; al.initp(p.H, 32, (long)mt * 256, false);
    GRow<2> bl; bl.initp(p.WRT, 32, (long)nt * 128, true);
    f32x4 acc[8][4]; zero_acc(acc);
    gemm_loop<true>(smem, al, bl, 32, acc);
    epi_rows(acc, [&](int r, int c0, const Row16& v) __attribute__((always_inline)) {
        float o[16];
#pragma unroll
        for (int q = 0; q < 16; ++q) o[q] = sigmoidf_(v.get(q));
        st16_f32(p.SCORES + ((long)mt * 256 + r) * 256 + nt * 128 + c0, o);
    });
}
DEV void phase8s(CParams& p, int mt, int nt, char* smem) {
    GRow<4> al; al.initp(p.H, 32, (long)mt * 256, false);
    GRow<2> bl; bl.initp(p.WSUPT, 32, (long)nt * 128, false);
    f32x4 acc[8][4]; zero_acc(acc);
    gemm_loop<true>(smem, al, bl, 32, acc);
    epi_rows(acc, [&](int r, int c0, const Row16& v) __attribute__((always_inline)) {
        float o[8];
#pragma unroll
        for (int q = 0; q < 8; ++q) o[q] = siluf_(v.get(q)) * v.get(8 + q);
        st8_bf16(p.HSH + pkl((long)mt * 256 + r, nt * 64 + (c0 >> 1), 8), o);
    });
}
DEV void phase8(CParams& p, char* smem) {
    const int x = blockIdx.x & 7, member = blockIdx.x >> 3, nmem = (gridDim.x - x + 7) >> 3;
    for (int j = member; j < 48; j += nmem) {
        if (j < 16) phase8r(p, x * 8 + (j & 7), j >> 3, smem);
        else phase8s(p, x * 8 + ((j - 16) & 7), (j - 16) >> 3, smem);
    }
}

constexpr int P9_TASKS = T_TOK / 32;
DEV void phase9(CParams& p, int task) {
    const int lane = TIDX & 63, t0 = (task * 4 + (TIDX >> 6)) * 8;
    int accE = 0; float accW = 0.f;
    const f32x4 bs = *(const f32x4*)(p.router_bias + lane * 4);
#pragma unroll 2
  for (int ti = 0; ti < 8; ++ti) {
    const int t = t0 + ti;
    const f32x4 s = *(const f32x4*)(p.SCORES + (long)t * 256 + lane * 4);
    float v0 = s[0] + bs[0], v1 = s[1] + bs[1], v2 = s[2] + bs[2], v3 = s[3] + bs[3];
    float m1, m2;
    { const float a = fmaxf(v0, v1), b = fminf(v0, v1), c = fmaxf(v2, v3), d = fminf(v2, v3); m1 = fmaxf(a, c); m2 = fmaxf(fminf(a, c), fmaxf(b, d)); }
#pragma unroll
    for (int off = 1; off <= 4; off <<= 1) {
        const float o1 = __shfl_xor(m1, off), o2 = __shfl_xor(m2, off);
        const float n1 = fmaxf(m1, o1), n2 = fmaxf(fminf(m1, o1), fmaxf(m2, o2));
        m1 = n1; m2 = n2;
    }
    const float gs = m1 + m2;
    const int myg = lane >> 3;
    int rank = 0;
#pragma unroll
    for (int j = 0; j < 8; ++j) { const float og = __shfl(gs, j * 8); rank += ((og > gs) || (og == gs && j < myg)) ? 1 : 0; }
    const float NEG = -__builtin_inff();
    if (rank >= 4) { v0 = NEG; v1 = NEG; v2 = NEG; v3 = NEG; }
    float wsum = 0.f, myS = 0.f; int myE = 0;
#pragma unroll
    for (int r = 0; r < 8; ++r) {
        float bv = v0; int bi = 0;
        if (v1 > bv) { bv = v1; bi = 1; }
        if (v2 > bv) { bv = v2; bi = 2; }
        if (v3 > bv) { bv = v3; bi = 3; }
        float rv = bv; int ri = lane * 4 + bi;
#pragma unroll
        for (int off = 32; off >= 1; off >>= 1) {
            const float ov = __shfl_xor(rv, off); const int oi = __shfl_xor(ri, off);
            if (ov > rv || (ov == rv && oi < ri)) { rv = ov; ri = oi; }
        }
        const int sel = ri & 3;
        const float ssel = (sel == 0) ? s[0] : (sel == 1) ? s[1] : (sel == 2) ? s[2] : s[3];
        const float sc = __shfl(ssel, ri >> 2);
        if ((ri >> 2) == lane) { if (sel == 0) v0 = NEG; else if (sel == 1) v1 = NEG; else if (sel == 2) v2 = NEG; else v3 = NEG; }
        if (lane == r) { myE = ri; myS = sc; }
        wsum += sc;
    }
    const float w = myS / wsum * 2.5f;
    const int eS = __shfl(myE, lane & 7); const float wS = __shfl(w, lane & 7);
    if ((lane >> 3) == ti) { accE = eS; accW = wS; }
  }
    {
        const int t = t0 + (lane >> 3), k = lane & 7;
        int pos = atomicAdd(&p.CNT[accE], 1);
        pos = pos < 0 ? 0 : (pos >= CAP ? CAP - 1 : pos);
        p.BTOK[(long)accE * CAP + pos] = t;
        p.ASG_E[t * 8 + k] = accE; p.ASG_P[t * 8 + k] = pos; p.ASG_W[t * 8 + k] = accW;
    }
}

DEV int pos_of_expert(int e) { return (e & 7) * 32 + (e >> 3); }
DEV int expert_of_pos(int q) { return (q & 31) * 8 + (q >> 5); }
DEV void build_tables(CParams& p, int* tab, int* scratch) {
    const int tid = TIDX;
    const int c = p.CNT[expert_of_pos(tid)];
    int* a = scratch; int* b2 = scratch + 256;
    a[tid] = (c + XM - 1) / XM; b2[tid] = c;
    __syncthreads();
    for (int off = 1; off < 256; off <<= 1) {
        const int va = (tid >= off) ? a[tid - off] : 0, vb = (tid >= off) ? b2[tid - off] : 0;
        __syncthreads();
        a[tid] += va; b2[tid] += vb;
        __syncthreads();
    }
    tab[tid + 1] = a[tid]; tab[257 + tid + 1] = b2[tid];
    if (tid == 0) { tab[0] = 0; tab[257] = 0; }
    __syncthreads();
}
DEV int rows_per_tile(int cnt, int tiles) { return (((cnt + tiles - 1) / tiles) + 31) & ~31; }
DEV void find_unit(const int* tab, int x, int NT, int u, int& q, int& nt, int& rt) {
    const int base = tab[32 * x];
    int lo = 32 * x, hi = 32 * x + 31;
    while (lo < hi) { const int mid = (lo + hi + 1) >> 1; if (NT * (tab[mid] - base) <= u) lo = mid; else hi = mid - 1; }
    q = lo;
    const int local = u - NT * (tab[q] - base), tiles = tab[q + 1] - tab[q];
    nt = local / tiles; rt = local - nt * tiles;
}

DEV void phase10(CParams& p, char* smem, bool rep) {
    int* tab = (int*)(smem + GEMM_SMEM);
    build_tables(p, tab, (int*)smem);
    const int x0 = blockIdx.x & 7;
    for (int gi = 0; gi < 8; ++gi) {
      const int x = (x0 + gi) & 7; unsigned* qh = q_head(p, 2, rep, x);
      const int U = 4 * (tab[32 * x + 32] - tab[32 * x]);
      for (;;) {
        const int u = dq_next(qh, smem); if (u >= U) break;
        int q, nt, rt; find_unit(tab, x, 4, u, q, nt, rt);
        const int e = expert_of_pos(q);
        const int cnt = tab[257 + q + 1] - tab[257 + q], rpt = rows_per_tile(cnt, tab[q + 1] - tab[q]);
        const int row0 = rt * rpt, s0 = tab[257 + q] + row0, valid = min(rpt, cnt - row0);
        XGather al; al.base = (const char*)p.H2F8; al.kstb = 64u;
        {
            const int kcs = gather_kcs();
#pragma unroll
            for (int i = 0; i < 5; ++i) { const int r = (TIDX >> 2) + 64 * i; const int tok = (r < valid) ? p.BTOK[(long)e * CAP + row0 + r] : 0; al.off[i] = (unsigned)tok * 1024u + (unsigned)kcs * 2u; }
        }
        int mat, jcol; up_row_map(nt, (TIDX & 31) * 4, mat, jcol);
        ColF8<256> bl; bl.colp = (mat ? p.w3 : p.w1) + (long)e * 262144 + jcol;
        f32x4 acc[10][4]; zero_acc10(acc);
        gemm_loop_x8(smem, al, bl, 16, valid, acc);
        unsigned char* hid_dst = rep ? (unsigned char*)p.OUTR : (unsigned char*)p.HID;
        epi_rows10(acc, [&](int r, int c0, const Row16& v) __attribute__((always_inline)) {
            if (r < valid) {
                float o[8];
#pragma unroll
                for (int qq = 0; qq < 8; ++qq) o[qq] = siluf_(v.get(qq) * W8_INV) * (v.get(8 + qq) * W8_INV);
                u32x2 w8; w8.x = pack4_fp8(o[0], o[1], o[2], o[3]); w8.y = pack4_fp8(o[4], o[5], o[6], o[7]);
                *(u32x2*)(hid_dst + pkl8(s0 + r, nt * 64 + (c0 >> 1), 4)) = w8;
            }
        });
      }
    }
}

DEV void phase10b(CParams& p, char* smem) {
    for (int idx = 0;; ++idx) {
        int mt, nt; if (!xcd_tile(idx, 64, 8, mt, nt)) break;
        GRow<4> al; al.initp(p.HSH, 8, (long)mt * 256, false);
        GRow<2> bl; bl.initp(p.WS2T, 8, (long)nt * 128, true);
        f32x4 acc[8][4]; zero_acc(acc);
        gemm_loop<true>(smem, al, bl, 8, acc);
        epi_rows(acc, [&](int r, int c0, const Row16& v) __attribute__((always_inline)) {
            const long t = (long)mt * 256 + r; const int col = nt * 128 + c0, b = (int)(t >> 13);
            float xv[16], gv[16], o[16];
            ld16_f32(p.X1 + t * 1024 + col, xv);
            ld16_f32(p.MOD + b * 6144 + 5120 + col, gv);
#pragma unroll
            for (int qq = 0; qq < 16; ++qq) o[qq] = xv[qq] + gv[qq] * v.get(qq);
            st16_f32(p.X1 + t * 1024 + col, o);
        });
    }
}

DEV void phase11(CParams& p, char* smem, bool rep) {
    int* tab = (int*)(smem + GEMM_SMEM);
    build_tables(p, tab, (int*)smem);
    const int x0 = blockIdx.x & 7;
    for (int gi = 0; gi < 8; ++gi) {
      const int x = (x0 + gi) & 7; unsigned* qh = q_head(p, 3, rep, x);
      const int U = 8 * (tab[32 * x + 32] - tab[32 * x]);
      for (;;) {
        const int u = dq_next(qh, smem); if (u >= U) break;
        int q, nt, rt; find_unit(tab, x, 8, u, q, nt, rt);
        const int e = expert_of_pos(q);
        const int cnt = tab[257 + q + 1] - tab[257 + q], rpt = rows_per_tile(cnt, tab[q + 1] - tab[q]);
        const int row0 = rt * rpt, s0 = tab[257 + q] + row0, valid = min(rpt, cnt - row0);
        XGather al; al.base = (const char*)p.HID; al.kstb = 128u;
        {
            const int kcs = gather_kcs();
#pragma unroll
            for (int i = 0; i < 5; ++i) al.off[i] = (unsigned)pkl8(s0 + (int)(TIDX >> 2) + 64 * i, 0, 4) + (unsigned)kcs * 2u;
        }
        ColF8<1024> bl; bl.colp = p.w2 + (long)e * 262144 + nt * 128 + bcol((TIDX & 31) * 4);
        f32x4 acc[10][4]; zero_acc10(acc);
        gemm_loop_x8(smem, al, bl, 4, valid, acc);
        epi_rows10(acc, [&](int r, int c0, const Row16& v) __attribute__((always_inline)) {
            if (r < valid) { Row16 s; s.a0 = v.a0 * W8_INV; s.a1 = v.a1 * W8_INV; s.a2 = v.a2 * W8_INV; s.a3 = v.a3 * W8_INV; st16_bf16(p.OUTR + (long)(s0 + r) * 1024 + nt * 128 + c0, s); }
        });
      }
    }
}

DEV void phase12(CParams& p, char* smem) {
    int* tab = (int*)(smem + GEMM_SMEM);
    build_tables(p, tab, (int*)smem);
    const int lane = TIDX & 63;
    for (int task = blockIdx.x; task < T_TOK / 4; task += gridDim.x) {
        const int t = task * 4 + (TIDX >> 6), b = t >> 13;
        float a[16];
#pragma unroll
        for (int i = 0; i < 16; ++i) a[i] = 0.f;
#pragma unroll
        for (int k = 0; k < 8; ++k) {
            const int e = p.ASG_E[t * 8 + k], pos = p.ASG_P[t * 8 + k];
            const float w = p.ASG_W[t * 8 + k];
            const bf16_t* row = p.OUTR + (long)(tab[257 + pos_of_expert(e)] + pos) * 1024;
#pragma unroll
            for (int hh = 0; hh < 2; ++hh) {
                const bf16x8 v = *(const bf16x8*)(row + hh * 512 + lane * 8);
#pragma unroll
                for (int q = 0; q < 8; ++q) a[hh * 8 + q] += w * bf2f((bf16_t)v[q]);
            }
        }
        float ss = 0.f;
#pragma unroll
        for (int hh = 0; hh < 2; ++hh) {
            const int c0 = hh * 512 + lane * 8;
            const f32x4 x0 = *(const f32x4*)(p.X1 + (long)t * 1024 + c0), x1 = *(const f32x4*)(p.X1 + (long)t * 1024 + c0 + 4);
            const f32x4 g0 = *(const f32x4*)(p.MOD + b * 6144 + 5120 + c0), g1 = *(const f32x4*)(p.MOD + b * 6144 + 5120 + c0 + 4);
#pragma unroll
            for (int q = 0; q < 4; ++q) { a[hh * 8 + q] = x0[q] + g0[q] * a[hh * 8 + q]; a[hh * 8 + 4 + q] = x1[q] + g1[q] * a[hh * 8 + 4 + q]; }
#pragma unroll
            for (int q = 0; q < 8; ++q) ss += a[hh * 8 + q] * a[hh * 8 + q];
        }
        ss = wave_sum(ss);
        const float rstd = rsqrtf(ss * (1.f / 1024.f) + 1e-6f);
#pragma unroll
        for (int hh = 0; hh < 2; ++hh) {
            const int c0 = hh * 512 + lane * 8;
            const f32x4 g0 = *(const f32x4*)(p.final_gain + c0), g1 = *(const f32x4*)(p.final_gain + c0 + 4);
            f32x4 o0, o1;
#pragma unroll
            for (int q = 0; q < 4; ++q) { o0[q] = a[hh * 8 + q] * rstd * g0[q]; o1[q] = a[hh * 8 + 4 + q] * rstd * g1[q]; }
            *(f32x4*)(p.out + (long)t * 1024 + c0) = o0; *(f32x4*)(p.out + (long)t * 1024 + c0 + 4) = o1;
        }
    }
}

DEV void run_p1(CParams& p, char* smem, bool rep) {
    const int x0 = blockIdx.x & 7;
    for (int gi = 0; gi < 8; ++gi) {
        const int x = (x0 + gi) & 7; unsigned* q = q_head(p, 0, rep, x);
        for (;;) { const int j = dq_next(q, smem); if (j >= 8 * 29) break; phase1(p, x * 8 + (j & 7), j >> 3, smem, rep); }
    }
    if (!rep) { unsigned* q = q_head(p, 5, rep, 0); for (;;) { const int j = dq_next(q, smem); if (j >= P0B_TOEP) break; phase0b_toep(p, j); } }
}
DEV void run_p0(CParams& p, char* smem, bool rep) {
    unsigned* modcnt = q_head(p, 4, rep, 0);
    for (int t = blockIdx.x; t < P0_TASKS; t += gridDim.x) phase0(p, t, smem, modcnt);
    __syncthreads();
    if (TIDX == 0) {
        unsigned sp = 0;
        while (__hip_atomic_load(modcnt, __ATOMIC_RELAXED, __HIP_MEMORY_SCOPE_AGENT) < (unsigned)P0_MOD) { __builtin_amdgcn_s_sleep(2); if (++sp > (1u << 22)) break; }
        __builtin_amdgcn_fence(__ATOMIC_ACQUIRE, "agent");
        asm volatile("s_waitcnt vmcnt(0)" ::: "memory");
    }
    __syncthreads();
    for (int t = blockIdx.x; t < P0B_ROWS; t += gridDim.x) phase0b_rows(p, t);
}
DEV void run_p5(CParams& p, char* smem, bool rep) {
    {
        unsigned* q = q_head(p, 1, rep, 0);
        for (;;) { const int j = dq_next(q, smem); if (j >= P5_SSD) break; phase5(p, ((j & 1023) << 1) | ((j >> 10) ^ 1), smem); }
    }
    {
        unsigned* q = q_head(p, 1, rep, 1);
        for (;;) { const int g = dq_next(q, smem); if (g >= 256) break; phase5glu(p, g >> 2, g & 3, smem); }
    }
}
DEV void run_p2(CParams& p, char* smem) {
    for (int t = blockIdx.x; t < P2_CONV; t += gridDim.x) phase2(p, t, smem);
    for (int t = blockIdx.x; t < P2_E; t += gridDim.x) phase2e5(p, t, smem);
}
DEV void run_p6(CParams& p, char* smem) { for (int i = 0;; ++i) { int mt, nt; if (!xcd_tile(i, 64, 8, mt, nt)) break; phase6(p, mt, nt, smem); } }

__global__ void __launch_bounds__(256, 2) fwd_kernel(Params p0) {
    extern __shared__ __attribute__((aligned(16))) char smem[];
    const bool multi = (p0.phase_hi - p0.phase_lo) > 1;
    if (multi) {
        if (TIDX == 0) { *(uint4*)(smem + SMEM_BYTES - 16) = make_uint4(0u, 0u, 0u, 0u); }
        __syncthreads();
        (void)xcd_barrier_post(p0.bar, (volatile LAS unsigned*)(smem + SMEM_BYTES - 16));
    }
#define XB_NOW() ({ XcdBarrier xb_; xb_.bar = ((CParams*)__builtin_amdgcn_kernarg_segment_ptr())->bar; xb_.x = xb_xcc_id(); xb_.st = (volatile LAS unsigned*)(smem + SMEM_BYTES - 16); xb_; })
    const int lo = p0.phase_lo, hi = p0.phase_hi, rp_ = p0.repeat_phase;
#define PH_RUN(n, body) if (lo <= (n) && (n) < hi) { const int nrep_ = ((n) == rp_) ? 2 : 1; for (int rep_ = 0; rep_ < nrep_; ++rep_) { if ((n) > lo || rep_ > 0) xcd_barrier(XB_NOW()); const bool rep = rep_ > 0; (void)rep; CParams* pp_ = (CParams*)__builtin_amdgcn_kernarg_segment_ptr(); asm volatile("" : "+s"(pp_)); CParams& p = *pp_; body } }
    PH_RUN(0, run_p0(p, smem, rep);)
    PH_RUN(2, run_p1(p, smem, rep);)
    PH_RUN(3, run_p2(p, smem);)
    PH_RUN(4, for (int t = blockIdx.x; t < P3_TASKS; t += gridDim.x) phase3(p, t, smem);)
    PH_RUN(5, for (int t = blockIdx.x; t < P4_TASKS; t += gridDim.x) phase4(p, t, smem);)
    PH_RUN(6, run_p5(p, smem, rep);)
    PH_RUN(7, run_p6(p, smem);)
    PH_RUN(8, for (int t = blockIdx.x; t < P7_TASKS; t += gridDim.x) phase7(p, t);)
    PH_RUN(9, phase8(p, smem);)
    PH_RUN(10, for (int t = blockIdx.x; t < P9_TASKS; t += gridDim.x) phase9(p, t);)
    PH_RUN(11, phase10(p, smem, rep); if (!rep) { CParams* q_ = (CParams*)__builtin_amdgcn_kernarg_segment_ptr(); asm volatile("" : "+s"(q_)); phase10b(*q_, smem); })
    PH_RUN(12, phase11(p, smem, rep);)
    PH_RUN(13, phase12(p, smem);)
}
constexpr int N_PH = 14;
static inline size_t al256(size_t v) { return (v + 255) & ~(size_t)255; }
extern "C" void kernel_launch(void* const* d_in, const int* in_sizes, int n_in, void* d_out, int out_size, void* d_ws, size_t ws_size, hipStream_t stream) {
    (void)in_sizes; (void)n_in; (void)out_size;
    Params p;
    ::memset((void*)&p, 0, sizeof(p));
    const float** ins = (const float**)&p.x;
    for (int i = 0; i < 34; ++i) ins[i] = (const float*)d_in[i];
    p.out = (float*)d_out;
    char* w = (char*)d_ws; size_t o = 0;
    auto carve = [&](size_t bytes) __attribute__((always_inline)) { char* r = w + o; o = al256(o + bytes); return r; };
    p.bar = (unsigned*)carve((XCD_BAR_WORDS + Q_WORDS) * 4);
    p.MOD = (float*)carve(2 * 6144 * 4);
    p.H = (bf16_t*)carve((size_t)T_TOK * 1024 * 2);
    p.WINT = (bf16_t*)carve((size_t)NPROJ_PAD * 1024 * 2);
    p.WOUTT = (bf16_t*)carve((size_t)1024 * 1536 * 2);
    p.WGLUT = (bf16_t*)carve((size_t)512 * 512 * 2);
    p.WRT = (bf16_t*)carve((size_t)256 * 1024 * 2);
    p.WSUPT = (bf16_t*)carve((size_t)512 * 1024 * 2);
    p.WS2T = (bf16_t*)carve((size_t)1024 * 256 * 2);
    p.KERN = (float*)carve((size_t)32 * 32 * 256 * 4);
    p.W5T = (bf16_t*)carve((size_t)32 * 512 * 640 * 2);
    p.E5T = (bf16_t*)carve((size_t)32 * 128 * 512 * 2);
    p.AQ = (float*)carve((size_t)32 * 64 * 2 * 4);
    p.Z = (bf16_t*)carve((size_t)T_TOK * 1024 * 2);
    p.XBCR = (bf16_t*)carve((size_t)T_TOK * 2048 * 2);
    p.DTR = (float*)carve((size_t)T_TOK * 16 * 4);
    p.UG = (bf16_t*)carve((size_t)32 * T_TOK * 16 * 2);
    p.XN = (bf16_t*)carve((size_t)T_TOK * 1024 * 2);
    p.BN = (bf16_t*)carve((size_t)T_TOK * 512 * 2);
    p.CN = (bf16_t*)carve((size_t)T_TOK * 512 * 2);
    p.XDTT = (bf16_t*)carve((size_t)T_TOK * 1024 * 2);
    p.XDECT = (bf16_t*)carve((size_t)T_TOK * 1024 * 2);
    p.BT = (bf16_t*)carve((size_t)T_TOK * 512 * 2);
    p.ACS = (float*)carve((size_t)2 * 16 * SEQ * 4);
    p.ST = (float*)carve((size_t)2 * 32 * 16 * 64 * 128 * 4);
    p.PREV = (bf16_t*)carve((size_t)2 * 32 * 16 * 64 * 128 * 2);
    p.E5 = (float*)carve((size_t)32 * 512 * 128 * 4);
    p.SPREV = (bf16_t*)carve((size_t)32 * 512 * 128 * 2);
    p.G5 = (bf16_t*)carve((size_t)T_TOK * 512 * 2);
    p.Y5 = (bf16_t*)carve((size_t)T_TOK * 512 * 2);
    p.YG = (bf16_t*)carve((size_t)T_TOK * 1024 * 2);
    p.SSQ = (float*)carve((size_t)T_TOK * 40 * 4);
    p.CNT = (int*)carve(256 * 4);
    p.X1 = (float*)carve((size_t)T_TOK * 1024 * 4);
    p.SCORES = (float*)carve((size_t)T_TOK * 256 * 4);
    p.BTOK = (int*)carve((size_t)NEXP * CAP * 4);
    p.ASG_E = (int*)carve((size_t)T_TOK * 8 * 4);
    p.ASG_P = (int*)carve((size_t)T_TOK * 8 * 4);
    p.ASG_W = (float*)carve((size_t)T_TOK * 8 * 4);
    p.HSH = (bf16_t*)carve((size_t)T_TOK * 256 * 2);
    p.HID = (bf16_t*)carve((size_t)(NSLOT + 320) * 256 * 2);
    p.H2F8 = (unsigned char*)carve((size_t)T_TOK * 1024);
    p.OUTR = (bf16_t*)carve((size_t)(NSLOT + 320) * 1024 * 2);
    p.DBG = (float*)carve(1024);
    if (o > ws_size) { fprintf(stderr, "workspace too small: need %zu have %zu\n", o, ws_size); return; }

    static int grid_blocks = 0;
    if (!grid_blocks) {
        int dev = 0, cus = 0, per_cu = 0;
        if (hipGetDevice(&dev) != hipSuccess || hipDeviceGetAttribute(&cus, hipDeviceAttributeMultiprocessorCount, dev) != hipSuccess) { fprintf(stderr, "kernel_launch: device query failed\n"); grid_blocks = -1; return; }
        if (hipFuncSetAttribute((const void*)fwd_kernel, hipFuncAttributeMaxDynamicSharedMemorySize, SMEM_BYTES) != hipSuccess) { fprintf(stderr, "kernel_launch: hipFuncSetAttribute failed\n"); grid_blocks = -1; return; }
        if (hipOccupancyMaxActiveBlocksPerMultiprocessor(&per_cu, (const void*)fwd_kernel, 256, SMEM_BYTES) != hipSuccess || per_cu < 1) { fprintf(stderr, "kernel_launch: occupancy query says %d\n", per_cu); per_cu = 1; }
        (void)hipGetLastError();
        if (per_cu > 2) per_cu = 2;
        grid_blocks = cus * per_cu;
    }
    if (grid_blocks < 0) return;
#if MULTI_LAUNCH
    (void)hipMemsetAsync(p.bar, 0, (XCD_BAR_WORDS + Q_WORDS) * 4, stream);
    for (int ph = 0; ph < N_PH && ph < MAX_PHASE; ++ph) {
        p.phase_lo = ph; p.phase_hi = ph + 1; p.repeat_phase = -1;
        hipLaunchKernelGGL(fwd_kernel, dim3(grid_blocks), dim3(256), SMEM_BYTES, stream, p);
    }
#else
    (void)hipMemsetAsync(p.bar, 0, (XCD_BAR_WORDS + Q_WORDS) * 4, stream);
    p.phase_lo = 0; p.phase_hi = N_PH; p.repeat_phase = REPEAT_PHASE;
    hipLaunchKernelGGL(fwd_kernel, dim3(grid_blocks), dim3(256), SMEM_BYTES, stream, p);
#endif
}
```

```cpp
#include <hip/hip_runtime.h>
#include <stdint.h>
#include <stdio.h>
#include <string.h>

#ifndef MULTI_LAUNCH
#define MULTI_LAUNCH 0
#endif
#ifndef MAX_PHASE
#define MAX_PHASE 99
#endif
#ifndef REPEAT_PHASE
#define REPEAT_PHASE -1
#endif
#ifndef PROBE_VARIANT
#define PROBE_VARIANT 0
#endif

#define DEV __device__ __forceinline__
#define LAS __attribute__((address_space(3)))
typedef unsigned short bf16_t;
typedef short bf16x8 __attribute__((ext_vector_type(8)));
typedef float f32x4 __attribute__((ext_vector_type(4)));
typedef unsigned u32x2 __attribute__((ext_vector_type(2)));
typedef unsigned u32x4 __attribute__((ext_vector_type(4)));

__device__ __forceinline__ unsigned tid_v_() { unsigned t = __builtin_amdgcn_workitem_id_x(); asm volatile("" : "+v"(t)); return t; }
#define TIDX (tid_v_())

constexpr int T_TOK = 16384, SEQ = 8192, DM = 1024;
constexpr int NPROJ = 3600, NPROJ_PAD = 3712;
constexpr int NEXP = 256, CAP = 16384, NSLOT = T_TOK * 8;
constexpr int S5Q = 32;
constexpr int NPHASE = 13;

typedef __bf16 hbf2 __attribute__((ext_vector_type(2)));
typedef float f32x2 __attribute__((ext_vector_type(2)));
DEV bf16_t f2bf(float f) { const __bf16 b = (__bf16)f; return __builtin_bit_cast(bf16_t, b); }
DEV float bf2f(bf16_t h) { return __uint_as_float(((unsigned)h) << 16); }
DEV unsigned pack2(float lo, float hi) { const f32x2 v = {lo, hi}; const hbf2 b = __builtin_convertvector(v, hbf2); return __builtin_bit_cast(unsigned, b); }
DEV float sigmoidf_(float v) { return __builtin_amdgcn_rcpf(1.f + __expf(-v)); }
DEV float siluf_(float v) { return v * __builtin_amdgcn_rcpf(1.f + __expf(-v)); }
DEV float gelu_tanh(float v) { float u = 0.7978845608028654f * (v + 0.044715f * v * v * v); float th = 1.f - 2.f * __builtin_amdgcn_rcpf(1.f + __expf(2.f * u)); return 0.5f * v * (1.f + th); }
DEV float wave_sum(float v) {
#pragma unroll
    for (int o = 32; o >= 1; o >>= 1) v += __shfl_xor(v, o);
    return v;
}

#define XB_TMO      128
#define XB_XCNT(j)  (256  + 64 * (j))
#define XB_XSUB(j)  (1280 + 64 * (j))
#define XB_XGEN(j)  (2304 + 64 * (j))
#define XB_TOP      3328
#define XB_TOPGEN   3392
#define XCD_BAR_WORDS 3456
#define XB_SPIN_CAP (1u << 20)
DEV unsigned xb_ld(unsigned* p) { return __hip_atomic_load(p, __ATOMIC_RELAXED, __HIP_MEMORY_SCOPE_AGENT); }
DEV unsigned xb_add(unsigned* p, unsigned v) { return __hip_atomic_fetch_add(p, v, __ATOMIC_RELAXED, __HIP_MEMORY_SCOPE_AGENT); }
DEV unsigned xb_xcc_id() { return (unsigned)__builtin_amdgcn_s_getreg((3 << 11) | 20) & 0xFu; }
#define XB_SPIN(cond, bar) do { unsigned _sp = 0; while (cond) { __builtin_amdgcn_s_sleep(1); \
    if ((++_sp & 255u) == 0u) { if (xb_ld(&(bar)[XB_TMO])) break; if (_sp > XB_SPIN_CAP) { atomicAdd(&(bar)[XB_TMO], 1u); break; } } } } while (0)
struct XcdBarrier { unsigned* bar; unsigned x; volatile LAS unsigned* st; };
DEV XcdBarrier xcd_barrier_post(unsigned* bar, volatile LAS unsigned* st) {
    XcdBarrier b; b.bar = bar; b.x = xb_xcc_id(); b.st = st;
    if (TIDX == 0) (void)xb_add(&bar[XB_XCNT(b.x)], 1u);
    return b;
}
DEV void xcd_barrier_complete(unsigned* bar, unsigned x, unsigned& nloc, unsigned& nx) {
    const unsigned G = gridDim.x * gridDim.y * gridDim.z;
    unsigned sum, cnt, mine, sp = 0u;
    for (;;) {
        sum = 0u; cnt = 0u; mine = 0u;
#pragma unroll
        for (unsigned j = 0; j < 16; ++j) { const unsigned c = xb_ld(&bar[XB_XCNT(j)]); sum += c; cnt += (c > 0u) ? 1u : 0u; mine = (j == x) ? c : mine; }
        if (sum == G) break;
        __builtin_amdgcn_s_sleep(1);
        if ((++sp & 255u) == 0u) { if (xb_ld(&bar[XB_TMO])) break; if (sp > XB_SPIN_CAP) { atomicAdd(&bar[XB_TMO], 1u); break; } }
    }
    nloc = mine > 0u ? mine : 1u; nx = cnt > 0u ? cnt : 1u;
}
DEV void xcd_barrier(const XcdBarrier& b) {
    asm volatile("s_waitcnt vmcnt(0)" ::: "memory");
    __syncthreads();
    if (TIDX == 0) {
        unsigned* bar = b.bar;
        __builtin_amdgcn_s_waitcnt(0);
        unsigned nloc = b.st[0], nx = b.st[1];
        if (nloc == 0u) { xcd_barrier_complete(bar, b.x, nloc, nx); b.st[0] = nloc; b.st[1] = nx; }
        const unsigned old = xb_add(&bar[XB_XSUB(b.x)], 1u);
        const unsigned gen = old / nloc;
        if (old + 1u == (gen + 1u) * nloc) {
            __builtin_amdgcn_fence(__ATOMIC_RELEASE, "agent");
            asm volatile("s_waitcnt vmcnt(0)" ::: "memory");
            const unsigned og = xb_add(&bar[XB_TOP], 1u);
            const unsigned tg = og / nx;
            if (og + 1u == (tg + 1u) * nx) xb_add(&bar[XB_TOPGEN], 1u);
            else XB_SPIN(xb_ld(&bar[XB_TOPGEN]) == tg, bar);
            __builtin_amdgcn_fence(__ATOMIC_ACQUIRE, "agent");
            xb_add(&bar[XB_XGEN(b.x)], 1u);
            asm volatile("s_waitcnt vmcnt(0)" ::: "memory");
        } else {
            XB_SPIN(xb_ld(&bar[XB_XGEN(b.x)]) == gen, bar);
            __builtin_amdgcn_fence(__ATOMIC_ACQUIRE, "agent");
            asm volatile("s_waitcnt vmcnt(0)" ::: "memory");
        }
    }
    __syncthreads();
}

struct Params {
    const float *x, *c, *w_ada, *b_ada, *norm1_gain, *w_in, *conv_w, *conv_b, *dt_bias, *ssd_a_log, *ssd_d, *ssd_norm_gain,
        *s5_a_re, *s5_a_im, *s5_log_dt, *s5_b_re, *s5_b_im, *s5_c_re, *s5_c_im, *s5_d, *w_glu, *b_glu, *s5_norm_gain, *w_out,
        *norm2_gain, *w_router, *router_bias, *w1, *w3, *w2, *ws1, *ws3, *ws2, *final_gain;
    float* out;
    unsigned* bar;
    float* MOD;
    bf16_t* H;
    bf16_t* WINT;
    bf16_t* WOUTT;
    bf16_t* WGLUT;
    bf16_t* WRT;
    bf16_t* WSUPT;
    bf16_t* WS2T;
    float* KERN;
    bf16_t* W5T;
    bf16_t* E5T;
    float* AQ;
    bf16_t* Z;
    bf16_t* XBCR;
    float* DTR;
    bf16_t* UG;
    bf16_t* XN;
    bf16_t* BN;
    bf16_t* CN;
    bf16_t* XDTT;
    bf16_t* XDECT;
    bf16_t* BT;
    float* ACS;
    float* ST;
    bf16_t* PREV;
    float* E5;
    bf16_t* SPREV;
    bf16_t* G5;
    bf16_t* Y5;
    bf16_t* YG;
    float* SSQ;
    int* CNT;
    float* X1;
    float* SCORES;
    int* BTOK;
    int* ASG_E;
    int* ASG_P;
    float* ASG_W;
    bf16_t* HSH;
    bf16_t* HID;
    unsigned char* H2F8;
    bf16_t* OUTR;
    float* DBG;
    int phase_lo, phase_hi, repeat_phase, pad_;
};

typedef const __attribute__((address_space(4))) Params CParams;

constexpr int BK = 32, ST_A = 256 * 64, ST_B = 128 * 64, STAGE_B = ST_A + ST_B;
constexpr int GEMM_SMEM = 3 * STAGE_B;
constexpr int SMEM_BYTES = GEMM_SMEM + 4096;
DEV unsigned tid_opaque() { unsigned t = __builtin_amdgcn_workitem_id_x(); asm volatile("" : "+v"(t)); return t; }
DEV long pkl(long r, int k, int KB) { return (((r >> 1) * KB + (k >> 5)) << 6) + ((r & 1) << 5) + (k & 31); }
DEV int bcol(int R) { return (R & 64) | (((R >> 2) & 3) << 4) | (((R >> 4) & 3) << 2) | (R & 3); }
DEV int swzF(int kc) { return (0x9C >> (2 * kc)) & 3; }
DEV int swzFinv(int c) { return (0x78 >> (2 * c)) & 3; }

template <int NI> struct GRow {
    const bf16_t* p0; long s64;
    DEV void init(const bf16_t* base, long ld, bool perm) {
        const int tid = TIDX, r0 = tid >> 2, kcs = swzFinv((tid & 3) ^ ((tid >> 4) & 3));
        p0 = base + (long)(perm ? bcol(r0) : r0) * ld + kcs * 8; s64 = 64 * ld; kst = BK;
    }
    int kst;
    DEV void initp(const bf16_t* base, int KB, long row0, bool perm, int kt0 = 0) {
        const int tid = TIDX, r0 = tid >> 2, kcs = swzFinv((tid & 3) ^ ((tid >> 4) & 3));
        const int r = perm ? bcol(r0) : r0;
        p0 = base + pkl(row0 + r, kt0 * 32, KB) + kcs * 8; s64 = (long)32 * KB * 64; kst = 64;
    }
    DEV void issue(int kt, char* img) {
        char* d = img + (TIDX >> 6) * 1024;
#pragma unroll
        for (int i = 0; i < NI; ++i) __builtin_amdgcn_global_load_lds((const unsigned*)(p0 + i * s64 + (long)kt * kst), (unsigned*)(d + i * 4096), 16, 0, 0);
    }
};
struct GGather {
    const char* base; unsigned off[4];
    DEV void issue(int kt, char* img) {
        char* d = img + (TIDX >> 6) * 1024;
#pragma unroll
        for (int i = 0; i < 4; ++i) __builtin_amdgcn_global_load_lds((const unsigned*)(base + (size_t)(off[i] + (unsigned)(kt * BK * 2))), (unsigned*)(d + i * 4096), 16, 0, 0);
    }
};
DEV int gather_kcs() { return swzFinv((TIDX & 3) ^ ((TIDX >> 4) & 3)) * 8; }
template <int LDN> struct ColF32 {
    const float* colp; f32x4 v[4];
    DEV void load(int kt) {
        const float* q = colp + (long)(kt * BK + (tid_opaque() >> 5) * 4) * LDN;
#pragma unroll
        for (int e = 0; e < 4; ++e) v[e] = *(const f32x4*)(q + (long)e * LDN);
    }
    DEV void store(char* img) {
        const unsigned t_ = tid_opaque(); const int R0 = (t_ & 31) * 4, ksub = t_ >> 5, kc = ksub >> 1, half = ksub & 1;
#pragma unroll
        for (int c = 0; c < 4; ++c) {
            const int row = R0 + c;
            u32x2 w; w.x = pack2(v[0][c], v[1][c]); w.y = pack2(v[2][c], v[3][c]);
            *(u32x2*)(img + row * 64 + ((((row >> 2) & 3) ^ swzF(kc)) * 16) + half * 8) = w;
        }
    }
};
DEV void zero_acc(f32x4 (&acc)[8][4]) {
#pragma unroll
    for (int m = 0; m < 8; ++m)
#pragma unroll
        for (int n = 0; n < 4; ++n) acc[m][n] = (f32x4){0.f, 0.f, 0.f, 0.f};
}
template <bool PF> DEV void mma_stage(const char* st, int aoff, int boff, f32x4 (&acc)[8][4]) {
    bf16x8 bf[4];
#pragma unroll
    for (int n = 0; n < 4; ++n) bf[n] = *(const bf16x8*)(st + ST_A + boff + n * 1024);
    bf16x8 a0 = *(const bf16x8*)(st + aoff), a1 = *(const bf16x8*)(st + aoff + 1024);
#pragma unroll
    for (int mp = 0; mp < 4; ++mp) {
        bf16x8 n0 = a0, n1 = a1;
        if (mp < 3) { n0 = *(const bf16x8*)(st + aoff + (2 * mp + 2) * 1024); n1 = *(const bf16x8*)(st + aoff + (2 * mp + 3) * 1024); }
        if (PF) __builtin_amdgcn_sched_barrier(0);
#pragma unroll
        for (int n = 0; n < 4; ++n) acc[2 * mp][n] = __builtin_amdgcn_mfma_f32_16x16x32_bf16(bf[n], a0, acc[2 * mp][n], 0, 0, 0);
#pragma unroll
        for (int n = 0; n < 4; ++n) acc[2 * mp + 1][n] = __builtin_amdgcn_mfma_f32_16x16x32_bf16(bf[n], a1, acc[2 * mp + 1][n], 0, 0, 0);
        a0 = n0; a1 = n1;
    }
}
DEV void mma_stage_part(const char* st, int aoff, int boff, int npair, f32x4 (&acc)[8][4]) {
    if (npair <= 0) return;
    bf16x8 bf[4];
#pragma unroll
    for (int n = 0; n < 4; ++n) bf[n] = *(const bf16x8*)(st + ST_A + boff + n * 1024);
#pragma unroll
    for (int mp = 0; mp < 4; ++mp) {
        if (mp < npair) {
            const bf16x8 a0 = *(const bf16x8*)(st + aoff + (2 * mp) * 1024), a1 = *(const bf16x8*)(st + aoff + (2 * mp + 1) * 1024);
#pragma unroll
            for (int n = 0; n < 4; ++n) acc[2 * mp][n] = __builtin_amdgcn_mfma_f32_16x16x32_bf16(bf[n], a0, acc[2 * mp][n], 0, 0, 0);
#pragma unroll
            for (int n = 0; n < 4; ++n) acc[2 * mp + 1][n] = __builtin_amdgcn_mfma_f32_16x16x32_bf16(bf[n], a1, acc[2 * mp + 1][n], 0, 0, 0);
        }
    }
}
DEV void frag_offsets(int& aoff, int& boff) {
    const int lane = TIDX & 63, wid = TIDX >> 6, wr = wid >> 1, wc = wid & 1, fr = lane & 15, fq = lane >> 4;
    const int fo = (((fr >> 2) & 3) ^ swzF(fq)) * 16;
    aoff = (wr * 128 + fr) * 64 + fo; boff = (wc * 64 + fr) * 64 + fo;
}
template <bool PFX = false, class AL, class BL>
DEV void gemm_loop(char* smem, AL& al, BL& bl, int nk, f32x4 (&acc)[8][4], bool rep = false) {
    int aoff, boff; frag_offsets(aoff, boff);
    const bool noMMA = rep && (PROBE_VARIANT == 2), noB = rep && (PROBE_VARIANT == 3 || PROBE_VARIANT == 5 || PROBE_VARIANT >= 7), noA = rep && (PROBE_VARIANT == 4 || PROBE_VARIANT == 5 || PROBE_VARIANT >= 7), noBar = rep && (PROBE_VARIANT == 6 || PROBE_VARIANT == 8 || PROBE_VARIANT == 9);
    char* pc = smem; char* pn = smem + STAGE_B; char* pnn = smem + 2 * STAGE_B;
    if (!noA) al.issue(0, pc); if (!noB) bl.issue(0, pc + ST_A);
    if (!noA) al.issue(1, pn); if (!noB) bl.issue(1, pn + ST_A);
    asm volatile("s_waitcnt vmcnt(0)" ::: "memory");
    __builtin_amdgcn_s_barrier();
#pragma unroll 1
    for (int kt = 0; kt < nk; ++kt) {
        const bool more = (kt + 2 < nk);
        if (more) { if (!noA) al.issue(kt + 2, pnn); if (!noB) bl.issue(kt + 2, pnn + ST_A); }
        if (rep && (PROBE_VARIANT == 7 || PROBE_VARIANT == 9)) {
            bf16x8 fa = {1, 2, 3, 4, 5, 6, 7, 8}; asm volatile("" : "+v"(fa));
#pragma unroll
            for (int m = 0; m < 8; ++m)
#pragma unroll
                for (int n = 0; n < 4; ++n) acc[m][n] = __builtin_amdgcn_mfma_f32_16x16x32_bf16(fa, fa, acc[m][n], 0, 0, 0);
        } else if (!noMMA) mma_stage<PFX>(pc, aoff, boff, acc);
        if (rep && PROBE_VARIANT != 0 && PROBE_VARIANT != 1) { asm volatile("s_waitcnt vmcnt(0)" ::: "memory"); }
        else { if (more) asm volatile("s_waitcnt vmcnt(6)" ::: "memory"); else asm volatile("s_waitcnt vmcnt(0)" ::: "memory"); }
        asm volatile("s_waitcnt lgkmcnt(0)" ::: "memory");
        if (!noBar) __builtin_amdgcn_s_barrier();
        char* t = pc; pc = pn; pn = pnn; pnn = t;
    }
}
template <class AL, class BL>
DEV void gemm_loop_regb(char* smem, AL& al, BL& bl, int nk, int valid, f32x4 (&acc)[8][4], bool rep = false) {
    int aoff, boff; frag_offsets(aoff, boff);
    const int npair = min(4, max(0, (valid - (int)(TIDX >> 7) * 128 + 31) >> 5));
    const bool noMMA = rep && (PROBE_VARIANT == 2), noB = rep && (PROBE_VARIANT == 3), noA = rep && (PROBE_VARIANT == 4);
    char* pc = smem; char* pn = smem + STAGE_B;
    if (!noA) al.issue(0, pc); if (!noB) bl.load(0); bl.store(pc + ST_A);
    asm volatile("s_waitcnt vmcnt(0)" ::: "memory");
    __syncthreads();
#pragma unroll 1
    for (int kt = 0; kt < nk; ++kt) {
        const bool more = (kt + 1 < nk);
        if (more) { if (!noA) al.issue(kt + 1, pn); if (!noB) bl.load(kt + 1); }
        if (!noMMA) { if (npair == 4) mma_stage<false>(pc, aoff, boff, acc); else mma_stage_part(pc, aoff, boff, npair, acc); }
        if (more) bl.store(pn + ST_A);
        asm volatile("s_waitcnt vmcnt(0)" ::: "memory");
        __syncthreads();
        char* t = pc; pc = pn; pn = t;
    }
}
constexpr int XM = 320, XST_A = XM * 64, XSTAGE = XST_A + ST_B;
struct XGather {
    const char* base; unsigned off[5]; unsigned kstb;
    DEV void issue(int kt, char* img) {
        char* d = img + (TIDX >> 6) * 1024;
#pragma unroll
        for (int i = 0; i < 5; ++i) __builtin_amdgcn_global_load_lds((const unsigned*)(base + (size_t)(off[i] + (unsigned)kt * kstb)), (unsigned*)(d + i * 4096), 16, 0, 0);
    }
};
DEV void zero_acc10(f32x4 (&acc)[10][4]) {
#pragma unroll
    for (int m = 0; m < 10; ++m)
#pragma unroll
        for (int n = 0; n < 4; ++n) acc[m][n] = (f32x4){0.f, 0.f, 0.f, 0.f};
}
DEV void mma_stage10(const char* st, int aoff, int boff, int npair, f32x4 (&acc)[10][4]) {
    if (npair <= 0) return;
    bf16x8 bf[4];
#pragma unroll
    for (int n = 0; n < 4; ++n) bf[n] = *(const bf16x8*)(st + XST_A + boff + n * 1024);
#pragma unroll
    for (int mp = 0; mp < 5; ++mp) {
        if (mp < npair) {
            const bf16x8 a0 = *(const bf16x8*)(st + aoff + (2 * mp) * 1024), a1 = *(const bf16x8*)(st + aoff + (2 * mp + 1) * 1024);
#pragma unroll
            for (int n = 0; n < 4; ++n) acc[2 * mp][n] = __builtin_amdgcn_mfma_f32_16x16x32_bf16(bf[n], a0, acc[2 * mp][n], 0, 0, 0);
#pragma unroll
            for (int n = 0; n < 4; ++n) acc[2 * mp + 1][n] = __builtin_amdgcn_mfma_f32_16x16x32_bf16(bf[n], a1, acc[2 * mp + 1][n], 0, 0, 0);
        }
    }
}
template <class AL, class BL>
DEV void gemm_loop_x(char* smem, AL& al, BL& bl, int nk, int valid, f32x4 (&acc)[10][4]) {
    const int lane = TIDX & 63, wid = TIDX >> 6, wr = wid >> 1, wc = wid & 1, fr = lane & 15, fq = lane >> 4;
    const int fo = (((fr >> 2) & 3) ^ swzF(fq)) * 16;
    const int aoff = (wr * 160 + fr) * 64 + fo, boff = (wc * 64 + fr) * 64 + fo;
    const int npair = min(5, max(0, (valid - wr * 160 + 31) >> 5));
    char* pc = smem; char* pn = smem + XSTAGE;
    al.issue(0, pc); bl.load(0); bl.store(pc + XST_A);
    asm volatile("s_waitcnt vmcnt(0)" ::: "memory");
    __syncthreads();
#pragma unroll 1
    for (int kt = 0; kt < nk; ++kt) {
        const bool more = (kt + 1 < nk);
        if (more) { al.issue(kt + 1, pn); bl.load(kt + 1); }
        mma_stage10(pc, aoff, boff, npair, acc);
        if (more) bl.store(pn + XST_A);
        asm volatile("s_waitcnt vmcnt(0)" ::: "memory");
        __syncthreads();
        char* t = pc; pc = pn; pn = t;
    }
}
typedef long i64_t;
constexpr float W8_SCALE = 64.f, W8_INV = 1.f / 64.f;
DEV unsigned pack4_fp8(float a, float b, float c, float d) { int v = __builtin_amdgcn_cvt_pk_fp8_f32(a, b, 0, false); v = __builtin_amdgcn_cvt_pk_fp8_f32(c, d, v, true); return (unsigned)v; }
DEV long pkl8(long r, int k, int KB) { return (((r >> 1) * KB + (k >> 6)) << 7) + ((r & 1) << 6) + (k & 63); }
template <int LDN> struct ColF8 {
    const float* colp; f32x4 v[8];
    DEV void load(int kt) {
        const float* q = colp + (long)(kt * 64 + (tid_opaque() >> 5) * 8) * LDN;
#pragma unroll
        for (int e = 0; e < 8; ++e) v[e] = *(const f32x4*)(q + (long)e * LDN);
    }
    DEV void store(char* img) {
        const unsigned t_ = TIDX; const int R0 = (t_ & 31) * 4, ksub = t_ >> 5, kc = ksub >> 1, half = ksub & 1;
#pragma unroll
        for (int c = 0; c < 4; ++c) {
            const int row = R0 + c;
            u32x2 w;
            w.x = pack4_fp8(W8_SCALE * v[0][c], W8_SCALE * v[1][c], W8_SCALE * v[2][c], W8_SCALE * v[3][c]);
            w.y = pack4_fp8(W8_SCALE * v[4][c], W8_SCALE * v[5][c], W8_SCALE * v[6][c], W8_SCALE * v[7][c]);
            *(u32x2*)(img + row * 64 + ((((row >> 2) & 3) ^ swzF(kc)) * 16) + half * 8) = w;
        }
    }
};
DEV void mma_stage10_f8(const char* st, int rowA, int rowB, int quad, int fq, int npair, f32x4 (&acc)[10][4]) {
    if (npair <= 0) return;
#pragma unroll
    for (int ks = 0; ks < 2; ++ks) {
        const int co = ((quad ^ swzF(ks * 2 + (fq >> 1))) * 16) + (fq & 1) * 8;
        i64_t bf[4];
#pragma unroll
        for (int n = 0; n < 4; ++n) bf[n] = *(const i64_t*)(st + XST_A + rowB + co + n * 1024);
#pragma unroll
        for (int mp = 0; mp < 5; ++mp) {
            if (mp < npair) {
                const i64_t a0 = *(const i64_t*)(st + rowA + co + (2 * mp) * 1024), a1 = *(const i64_t*)(st + rowA + co + (2 * mp + 1) * 1024);
#pragma unroll
                for (int n = 0; n < 4; ++n) acc[2 * mp][n] = __builtin_amdgcn_mfma_f32_16x16x32_fp8_fp8(bf[n], a0, acc[2 * mp][n], 0, 0, 0);
#pragma unroll
                for (int n = 0; n < 4; ++n) acc[2 * mp + 1][n] = __builtin_amdgcn_mfma_f32_16x16x32_fp8_fp8(bf[n], a1, acc[2 * mp + 1][n], 0, 0, 0);
            }
        }
    }
}
template <class AL, class BL>
DEV void gemm_loop_x8(char* smem, AL& al, BL& bl, int nk, int valid, f32x4 (&acc)[10][4]) {
    const int lane = TIDX & 63, wid = TIDX >> 6, wr = wid >> 1, wc = wid & 1, fr = lane & 15, fq = lane >> 4;
    const int rowA = (wr * 160 + fr) * 64, rowB = (wc * 64 + fr) * 64, quad = (fr >> 2) & 3;
    const int npair = min(5, max(0, (valid - wr * 160 + 31) >> 5));
    char* pc = smem; char* pn = smem + XSTAGE;
    al.issue(0, pc); bl.load(0); bl.store(pc + XST_A);
    asm volatile("s_waitcnt vmcnt(0)" ::: "memory");
    __syncthreads();
#pragma unroll 1
    for (int kt = 0; kt < nk; ++kt) {
        const bool more = (kt + 1 < nk);
        if (more) { al.issue(kt + 1, pn); bl.load(kt + 1); }
        mma_stage10_f8(pc, rowA, rowB, quad, fq, npair, acc);
        if (more) bl.store(pn + XST_A);
        asm volatile("s_waitcnt vmcnt(0)" ::: "memory");
        __syncthreads();
        char* t = pc; pc = pn; pn = t;
    }
}
struct Row16 {
    f32x4 a0, a1, a2, a3;
    DEV float get(int q) const { return (q < 4) ? a0[q & 3] : (q < 8) ? a1[q & 3] : (q < 12) ? a2[q & 3] : a3[q & 3]; }
};
template <class F> DEV void epi_rows(const f32x4 (&acc)[8][4], F fn) {
    const int lane = TIDX & 63, wid = TIDX >> 6, wr = wid >> 1, wc = wid & 1, fr = lane & 15, fq = lane >> 4;
#pragma unroll
    for (int m = 0; m < 8; ++m) {
        Row16 v; v.a0 = acc[m][0]; v.a1 = acc[m][1]; v.a2 = acc[m][2]; v.a3 = acc[m][3];
        fn(wr * 128 + m * 16 + fr, wc * 64 + fq * 16, v);
        __builtin_amdgcn_sched_barrier(0);
    }
}
template <class F> DEV void epi_rows10(const f32x4 (&acc)[10][4], F fn) {
    const int lane = TIDX & 63, wid = TIDX >> 6, wr = wid >> 1, wc = wid & 1, fr = lane & 15, fq = lane >> 4;
#pragma unroll
    for (int m = 0; m < 10; ++m) {
        Row16 v; v.a0 = acc[m][0]; v.a1 = acc[m][1]; v.a2 = acc[m][2]; v.a3 = acc[m][3];
        fn(wr * 160 + m * 16 + fr, wc * 64 + fq * 16, v);
        __builtin_amdgcn_sched_barrier(0);
    }
}
DEV void st16_bf16(bf16_t* d, const Row16& v) {
    u32x4 a, b;
    a.x = pack2(v.a0[0], v.a0[1]); a.y = pack2(v.a0[2], v.a0[3]); a.z = pack2(v.a1[0], v.a1[1]); a.w = pack2(v.a1[2], v.a1[3]);
    b.x = pack2(v.a2[0], v.a2[1]); b.y = pack2(v.a2[2], v.a2[3]); b.z = pack2(v.a3[0], v.a3[1]); b.w = pack2(v.a3[2], v.a3[3]);
    *(u32x4*)d = a; *(u32x4*)(d + 8) = b;
}
DEV void st16_f32(float* d, const Row16& v) { *(f32x4*)d = v.a0; *(f32x4*)(d + 4) = v.a1; *(f32x4*)(d + 8) = v.a2; *(f32x4*)(d + 12) = v.a3; }
DEV void st16_bf16(bf16_t* d, const float* v) {
    u32x4 a, b;
    a.x = pack2(v[0], v[1]); a.y = pack2(v[2], v[3]); a.z = pack2(v[4], v[5]); a.w = pack2(v[6], v[7]);
    b.x = pack2(v[8], v[9]); b.y = pack2(v[10], v[11]); b.z = pack2(v[12], v[13]); b.w = pack2(v[14], v[15]);
    *(u32x4*)d = a; *(u32x4*)(d + 8) = b;
}
DEV void st8_bf16(bf16_t* d, const float* v) {
    u32x4 a; a.x = pack2(v[0], v[1]); a.y = pack2(v[2], v[3]); a.z = pack2(v[4], v[5]); a.w = pack2(v[6], v[7]);
    *(u32x4*)d = a;
}
DEV void st16_f32(float* d, const float* v) {
#pragma unroll
    for (int q = 0; q < 4; ++q) *(f32x4*)(d + 4 * q) = (f32x4){v[4 * q], v[4 * q + 1], v[4 * q + 2], v[4 * q + 3]};
}
DEV void ld16_f32(const float* s, float* v) {
#pragma unroll
    for (int q = 0; q < 4; ++q) { const f32x4 t = *(const f32x4*)(s + 4 * q); v[4 * q] = t[0]; v[4 * q + 1] = t[1]; v[4 * q + 2] = t[2]; v[4 * q + 3] = t[3]; }
}
DEV void ld16_bf16(const bf16_t* s, float* v) {
    const bf16x8 a = *(const bf16x8*)s, b = *(const bf16x8*)(s + 8);
#pragma unroll
    for (int q = 0; q < 8; ++q) { v[q] = bf2f((bf16_t)a[q]); v[8 + q] = bf2f((bf16_t)b[q]); }
}
DEV float sum_fq(float s) { s += __shfl_xor(s, 16); s += __shfl_xor(s, 32); return s; }

DEV void up_row_map(int nt, int R, int& mat, int& j) { const int wc = R >> 6, n = (R >> 4) & 3, fq = (R >> 2) & 3, reg = R & 3; mat = n >> 1; j = nt * 64 + wc * 32 + fq * 8 + (n & 1) * 4 + reg; }
DEV int win_src_col(int nd) { if (nd < 3072) return nd; if (nd < 3584) return nd + 16; if (nd < 3600) return nd - 512; return -1; }

template <class F> DEV void transpose_tile(char* smem, F srcfn, bf16_t* dst, int ldd, int k0, int nd0, bool pk = false) {
    float* t = (float*)smem;
    const int tid = TIDX, a = tid & 63, q = tid >> 6;
#pragma unroll 4
    for (int i = 0; i < 16; ++i) { const int k = q + 4 * i; t[k * 65 + a] = srcfn(k0 + k, nd0 + a); }
    __syncthreads();
#pragma unroll 4
    for (int i = 0; i < 16; ++i) { const int nl = q + 4 * i; const long o = pk ? pkl(nd0 + nl, k0 + a, ldd >> 5) : (long)(nd0 + nl) * ldd + k0 + a; dst[o] = f2bf(t[a * 65 + nl]); }
    __syncthreads();
}
DEV void s5_disc(CParams& p, int g, int n, float& lr, float& rev, float& f_re, float& f_im) {
    const float dt = __expf(p.s5_log_dt[g]);
    const float lre = fminf(p.s5_a_re[g * 64 + n], -1e-4f), lim = p.s5_a_im[g * 64 + n];
    lr = lre * dt; rev = lim * dt * 0.15915494309189535f;
    const float mag = __expf(lr), fr_ = __builtin_amdgcn_fractf(rev);
    const float ab_re = mag * __builtin_amdgcn_cosf(fr_), ab_im = mag * __builtin_amdgcn_sinf(fr_);
    const float den = lre * lre + lim * lim, num_re = ab_re - 1.f;
    f_re = (num_re * lre + ab_im * lim) / den; f_im = (ab_im * lre - num_re * lim) / den;
}
DEV void cpow(float lr, float rev, float tau, float& re, float& im) {
    const float mag = __expf(lr * tau), fr_ = __builtin_amdgcn_fractf(rev * tau);
    re = mag * __builtin_amdgcn_cosf(fr_); im = mag * __builtin_amdgcn_sinf(fr_);
}

constexpr int P0_MOD = 192, P0_WIN = 16 * 58, P0_WOUT = 24 * 16, P0_WGLU = 64, P0_WR = 64, P0_WSUP = 128, P0_WS2 = 64, P0_KERN = 1024, P0_W5S = 1024, P0_E5 = 1024, P0_ZERO = 16;
constexpr int P0_TASKS = P0_MOD + P0_WIN + P0_WOUT + P0_WGLU + P0_WR + P0_WSUP + P0_WS2 + P0_KERN + P0_W5S + P0_E5 + P0_ZERO;

DEV void phase0(CParams& p, int task, char* smem, unsigned* modcnt) {
    const int tid = TIDX;
    if (task < P0_MOD) {
        const int c4 = tid & 7, kq = tid >> 3, n0 = task * 32 + c4 * 4;
        f32x4 a0 = {0.f, 0.f, 0.f, 0.f}, a1 = {0.f, 0.f, 0.f, 0.f};
        for (int k0 = kq; k0 < 1024; k0 += 256) {
            f32x4 w[8]; float c0[8], c1[8];
#pragma unroll
            for (int u = 0; u < 8; ++u) { const int k = k0 + 32 * u; w[u] = *(const f32x4*)(p.w_ada + (long)k * 6144 + n0); c0[u] = p.c[k]; c1[u] = p.c[1024 + k]; }
#pragma unroll
            for (int u = 0; u < 8; ++u) { a0 += siluf_(c0[u]) * w[u]; a1 += siluf_(c1[u]) * w[u]; }
        }
        float* red = (float*)smem;
        *(f32x4*)(red + (kq * 8 + c4) * 8) = a0; *(f32x4*)(red + (kq * 8 + c4) * 8 + 4) = a1;
        __syncthreads();
        if (tid < 64) {
            const int b = tid >> 5, col = tid & 31, c4o = col >> 2, e = col & 3;
            float s = 0.f;
            for (int q = 0; q < 32; ++q) s += red[(q * 8 + c4o) * 8 + b * 4 + e];
            p.MOD[b * 6144 + task * 32 + col] = s + p.b_ada[task * 32 + col];
        }
        asm volatile("s_waitcnt vmcnt(0)" ::: "memory");
        __syncthreads();
        if (tid == 0) {
            __builtin_amdgcn_fence(__ATOMIC_RELEASE, "agent");
            asm volatile("s_waitcnt vmcnt(0)" ::: "memory");
            __hip_atomic_fetch_add(modcnt, 1u, __ATOMIC_RELAXED, __HIP_MEMORY_SCOPE_AGENT);
        }
        return;
    }
    task -= P0_MOD;
    if (task < P0_WIN) {
        const int kt = task / 58, nt = task % 58;
        transpose_tile(smem, [&](int k, int nd) __attribute__((always_inline)) { const int sc = win_src_col(nd); return sc < 0 ? 0.f : p.w_in[(long)k * NPROJ + sc]; }, p.WINT, 1024, kt * 64, nt * 64, true);
        return;
    }
    task -= P0_WIN;
    if (task < P0_WOUT) {
        const int kt = task / 16, nt = task % 16;
        transpose_tile(smem, [&](int k, int nd) __attribute__((always_inline)) { const float g = (k < 1024) ? p.ssd_norm_gain[k] : p.s5_norm_gain[k - 1024]; return g * p.w_out[(long)k * 1024 + nd]; }, p.WOUTT, 1536, kt * 64, nt * 64, true);
        return;
    }
    task -= P0_WOUT;
    if (task < P0_WGLU) {
        const int kt = task / 8, nt = task % 8;
        transpose_tile(smem, [&](int k, int nd) __attribute__((always_inline)) { return p.w_glu[(long)k * 512 + nd]; }, p.WGLUT, 512, kt * 64, nt * 64, true);
        return;
    }
    task -= P0_WGLU;
    if (task < P0_WR) {
        const int kt = task / 4, nt = task % 4;
        transpose_tile(smem, [&](int k, int nd) __attribute__((always_inline)) { return p.w_router[(long)k * 256 + nd]; }, p.WRT, 1024, kt * 64, nt * 64, true);
        return;
    }
    task -= P0_WR;
    if (task < P0_WSUP) {
        const int kt = task / 8, nt = task % 8;
        transpose_tile(smem, [&](int k, int nd) __attribute__((always_inline)) { int mat, j; up_row_map(nd >> 7, nd & 127, mat, j); return (mat ? p.ws3 : p.ws1)[(long)k * 256 + j]; }, p.WSUPT, 1024, kt * 64, nt * 64, true);
        return;
    }
    task -= P0_WSUP;
    if (task < P0_WS2) {
        const int kt = task / 16, nt = task % 16;
        transpose_tile(smem, [&](int k, int nd) __attribute__((always_inline)) { return p.ws2[(long)k * 1024 + nd]; }, p.WS2T, 256, kt * 64, nt * 64, true);
        return;
    }
    task -= P0_WS2;
    float* sG = (float*)smem;
    if (task < P0_KERN) {
        const int g = task >> 5, tau = task & 31;
        if (tid < 64) {
            float lr, rev, fre, fim, pr, pi; s5_disc(p, g, tid, lr, rev, fre, fim); cpow(lr, rev, (float)tau, pr, pi);
            sG[tid * 2] = pr * fre - pi * fim; sG[tid * 2 + 1] = pr * fim + pi * fre;
        }
        __syncthreads();
        const int pp = tid >> 4, q = tid & 15;
        float s = 0.f;
        for (int n = 0; n < 64; ++n) {
            const float cr = p.s5_c_re[(g * 16 + pp) * 64 + n], ci = p.s5_c_im[(g * 16 + pp) * 64 + n];
            const float gr = sG[n * 2], gi = sG[n * 2 + 1];
            const float xr = cr * gr - ci * gi, xi = cr * gi + ci * gr;
            const float br = p.s5_b_re[(g * 64 + n) * 16 + q], bi = p.s5_b_im[(g * 64 + n) * 16 + q];
            s += xr * br - xi * bi;
        }
        p.KERN[(long)(g * 32 + tau) * 256 + tid] = s;
        __syncthreads();
        return;
    }
    task -= P0_KERN;
    if (task < P0_W5S) {
        const int g = task >> 5, tp = task & 31;
        if (tid < 64) { float lr, rev, fre, fim, pr, pi; s5_disc(p, g, tid, lr, rev, fre, fim); cpow(lr, rev, (float)(tp + 1), pr, pi); sG[tid * 2] = pr; sG[tid * 2 + 1] = pi; }
        __syncthreads();
#pragma unroll
        for (int i = 0; i < 8; ++i) {
            const int idx = tid + 256 * i, pp = idx >> 7, m = idx & 127, n = m & 63;
            const float cr = p.s5_c_re[(g * 16 + pp) * 64 + n], ci = p.s5_c_im[(g * 16 + pp) * 64 + n];
            const float gr = sG[n * 2], gi = sG[n * 2 + 1];
            const float v = (m < 64) ? (cr * gr - ci * gi) : -(cr * gi + ci * gr);
            p.W5T[(long)g * 512 * 640 + pkl(tp * 16 + pp, 512 + m, 20)] = f2bf(v);
        }
        __syncthreads();
        return;
    }
    task -= P0_W5S;
    if (task < P0_E5) {
        const int g = task >> 5, jp = task & 31;
        if (tid < 64) {
            float lr, rev, fre, fim, pr, pi; s5_disc(p, g, tid, lr, rev, fre, fim); cpow(lr, rev, (float)(S5Q - 1 - jp), pr, pi);
            sG[tid * 2] = pr * fre - pi * fim; sG[tid * 2 + 1] = pr * fim + pi * fre;
            if (jp == 0) { float qr, qi; cpow(lr, rev, (float)S5Q, qr, qi); p.AQ[(g * 64 + tid) * 2] = qr; p.AQ[(g * 64 + tid) * 2 + 1] = qi; }
        }
        __syncthreads();
#pragma unroll
        for (int i = 0; i < 8; ++i) {
            const int idx = tid + 256 * i, m = idx >> 4, q = idx & 15, n = m & 63;
            const float gr = sG[n * 2], gi = sG[n * 2 + 1];
            const float br = p.s5_b_re[(g * 64 + n) * 16 + q], bi = p.s5_b_im[(g * 64 + n) * 16 + q];
            const float v = (m < 64) ? (gr * br - gi * bi) : (gr * bi + gi * br);
            p.E5T[(long)g * 128 * 512 + pkl(m, jp * 16 + q, 16)] = f2bf(v);
        }
        __syncthreads();
        return;
    }
    task -= P0_E5;
    {
        if (task == 0) p.CNT[tid] = 0;
    }
}

DEV void modnorm_row(const float* src, int row, const float* gain, const float* sc, const float* sh, const float* ssq, bf16_t* dst, unsigned char* dst8 = nullptr) {
    const int lane = TIDX & 63;
    const float* xr = src + (long)row * 1024;
    f32x4 v[4];
#pragma unroll
    for (int i = 0; i < 4; ++i) v[i] = *(const f32x4*)(xr + lane * 4 + 256 * i);
    float ss;
    if (ssq) { ss = 0.f;
#pragma unroll
        for (int q = 0; q < 16; ++q) ss += ssq[(long)row * 16 + q]; }
    else {
        ss = 0.f;
#pragma unroll
        for (int i = 0; i < 4; ++i) ss += v[i][0] * v[i][0] + v[i][1] * v[i][1] + v[i][2] * v[i][2] + v[i][3] * v[i][3];
        ss = wave_sum(ss);
    }
    const float rstd = rsqrtf(ss * (1.f / 1024.f) + 1e-6f);
#pragma unroll
    for (int i = 0; i < 4; ++i) {
        const int c = lane * 4 + 256 * i;
        const f32x4 g = *(const f32x4*)(gain + c), s1 = *(const f32x4*)(sc + c), s0 = *(const f32x4*)(sh + c);
        float o[4];
#pragma unroll
        for (int e = 0; e < 4; ++e) o[e] = v[i][e] * rstd * g[e] * (1.f + s1[e]) + s0[e];
        u32x2 w; w.x = pack2(o[0], o[1]); w.y = pack2(o[2], o[3]);
        *(u32x2*)(dst + pkl(row, c, 32)) = w;
        if (dst8) *(unsigned*)(dst8 + (long)row * 1024 + c) = pack4_fp8(o[0], o[1], o[2], o[3]);
    }
}
constexpr int P0B_ROWS = T_TOK / 4, P0B_TOEP = 1024;
DEV void phase0b_rows(CParams& p, int task) {
    const int row = task * 4 + (TIDX >> 6), b = row >> 13;
    modnorm_row(p.x, row, p.norm1_gain, p.MOD + b * 6144 + 1024, p.MOD + b * 6144, nullptr, p.H);
}
DEV void phase0b_toep(CParams& p, int task) {
    const int g = task >> 5, tp = task & 31;
#pragma unroll
    for (int i = 0; i < 4; ++i) {
        const int idx = TIDX + 256 * i, pp = idx >> 6, kc8 = (idx & 63) * 8, jp = kc8 >> 4, q0 = kc8 & 15;
        float v[8];
        if (jp <= tp) {
            const float* s = p.KERN + (long)(g * 32 + (tp - jp)) * 256 + pp * 16 + q0;
            const f32x4 a = *(const f32x4*)s, b4 = *(const f32x4*)(s + 4);
#pragma unroll
            for (int q = 0; q < 4; ++q) { v[q] = a[q]; v[4 + q] = b4[q]; }
        } else {
#pragma unroll
            for (int q = 0; q < 8; ++q) v[q] = 0.f;
        }
        st8_bf16(p.W5T + (long)g * 512 * 640 + pkl(tp * 16 + pp, kc8, 20), v);
    }
}

DEV bool xcd_tile(int idx, int MT, int NT, int& mt, int& nt) {
    const int x = blockIdx.x & 7, member = blockIdx.x >> 3, nmem = (gridDim.x - x + 7) >> 3;
    const int per = MT >> 3, j = member + idx * nmem;
    if (j >= per * NT) return false;
    mt = x * per + j % per; nt = j / per; return true;
}

constexpr int Q_SLOTS = 8, Q_WORDS = Q_SLOTS * 2 * 8 * 16;
DEV unsigned* q_head(CParams& p, int slot, bool rep, int group) { return p.bar + XCD_BAR_WORDS + ((slot * 2 + (rep ? 1 : 0)) * 8 + group) * 16; }
DEV int dq_next(unsigned* q, char* smem) {
    volatile LAS unsigned* w = (volatile LAS unsigned*)(smem + SMEM_BYTES - 32);
    __syncthreads();
    if (TIDX == 0) *w = __hip_atomic_fetch_add(q, 1u, __ATOMIC_RELAXED, __HIP_MEMORY_SCOPE_AGENT);
    __syncthreads();
    return (int)*w;
}

constexpr int P1_TASKS = 64 * 29;
DEV void phase1(CParams& p, int mt, int nt, char* smem, bool rep = false) {
    GRow<4> al; al.initp(p.H, 32, (long)mt * 256, false);
    GRow<2> bl; bl.initp(p.WINT, 32, (long)nt * 128, true);
    f32x4 acc[8][4]; zero_acc(acc);
    gemm_loop<true>(smem, al, bl, 32, acc, rep);
    epi_rows(acc, [&](int r, int c0, const Row16& v) __attribute__((always_inline)) {
        const long t = (long)mt * 256 + r;
        if (rep) { st16_bf16(p.OUTR + t * 4096 + nt * 128 + c0, v); return; }
        if (nt < 8) st16_bf16(p.Z + t * 1024 + nt * 128 + c0, v);
        else if (nt < 24) st16_bf16(p.XBCR + t * 2048 + (nt - 8) * 128 + c0, v);
        else if (nt < 28) { const int g = ((nt - 24) * 128 + c0) >> 4; st16_bf16(p.UG + (long)g * T_TOK * 16 + pkl(t >> 5, (int)(t & 31) * 16, 16), v); }
        else if (c0 == 0) st16_f32(p.DTR + t * 16, v);
    });
}

constexpr int P2_CONV = 2048, P2_E = 64, P2_TASKS = P2_CONV + P2_E;
DEV void phase2(CParams& p, int task, char* smem) {
    const int tid = TIDX;
    if (task < P2_CONV) {
        const int b = task >> 10, c = (task >> 5) & 31, cb = task & 31;
        float* sT = (float*)smem;
        float* sdt = sT + 64 * 257;
        float* sdec = sdt + 256;
        float* sscan = sdec + 256;
        const bool isx = cb < 16;
        if (isx) {
            const int h = cb;
            const float raw = p.DTR[((long)b * SEQ + c * 256 + tid) * 16 + h] + p.dt_bias[h];
            const float dtv = raw > 20.f ? raw : log1pf(__expf(raw));
            const float a = -__expf(p.ssd_a_log[h]);
            sscan[tid] = dtv * a;
            __syncthreads();
            for (int off = 1; off < 256; off <<= 1) {
                const float v = (tid >= off) ? sscan[tid - off] : 0.f;
                __syncthreads();
                sscan[tid] += v;
                __syncthreads();
            }
            const float acs = sscan[tid], aend = sscan[255];
            p.ACS[((long)b * 16 + h) * SEQ + c * 256 + tid] = acs;
            sdt[tid] = dtv; sdec[tid] = dtv * __expf(aend - acs);
        }
        __syncthreads();
        {
            const int cg = tid & 7, tg = tid >> 3, gch0 = cb * 64 + cg * 8, t0 = c * 256 + tg * 8;
            float w[4][8], bias[8];
#pragma unroll
            for (int k = 0; k < 4; ++k) { const f32x4 a = *(const f32x4*)(p.conv_w + k * 2048 + gch0), b4 = *(const f32x4*)(p.conv_w + k * 2048 + gch0 + 4);
#pragma unroll
                for (int q = 0; q < 4; ++q) { w[k][q] = a[q]; w[k][4 + q] = b4[q]; } }
            { const f32x4 a = *(const f32x4*)(p.conv_b + gch0), b4 = *(const f32x4*)(p.conv_b + gch0 + 4);
#pragma unroll
              for (int q = 0; q < 4; ++q) { bias[q] = a[q]; bias[4 + q] = b4[q]; } }
            const bf16_t* rawp = p.XBCR + (long)b * SEQ * 2048 + gch0;
            bf16x8 rows[11];
#pragma unroll
            for (int i = 0; i < 11; ++i) { const int t = t0 - 3 + i; rows[i] = (t >= 0) ? *(const bf16x8*)(rawp + (long)t * 2048) : (bf16x8){0, 0, 0, 0, 0, 0, 0, 0}; }
            float v[8][8];
#pragma unroll
            for (int i = 0; i < 8; ++i)
#pragma unroll
                for (int q = 0; q < 8; ++q) {
                    float s = bias[q];
#pragma unroll
                    for (int k = 0; k < 4; ++k) s += w[k][q] * bf2f((bf16_t)rows[i + k][q]);
                    v[i][q] = siluf_(s);
                }
            bf16_t* natp; long nld;
            if (cb < 16) { natp = p.XN + gch0; nld = 1024; } else if (cb < 24) { natp = p.BN + (gch0 - 1024); nld = 512; } else { natp = p.CN + (gch0 - 1536); nld = 512; }
#pragma unroll
            for (int i = 0; i < 8; ++i) st8_bf16(natp + ((long)b * SEQ + t0 + i) * nld, v[i]);
            if (isx) {
                float dtv[8], dcv[8];
#pragma unroll
                for (int i = 0; i < 8; ++i) { dtv[i] = sdt[tg * 8 + i]; dcv[i] = sdec[tg * 8 + i]; }
#pragma unroll
                for (int q = 0; q < 8; ++q) {
                    float a[8], d[8];
#pragma unroll
                    for (int i = 0; i < 8; ++i) { a[i] = v[i][q] * dtv[i]; d[i] = v[i][q] * dcv[i]; }
                    const long o = (((long)b * 16 + cb) * 64 + cg * 8 + q) * SEQ + t0;
                    st8_bf16(p.XDTT + o, a); st8_bf16(p.XDECT + pkl(((long)b * 16 + cb) * 64 + cg * 8 + q, t0, 256), d);
                }
            } else if (cb < 24) {
                const int g = (cb - 16) >> 1, half = (cb - 16) & 1;
#pragma unroll
                for (int q = 0; q < 8; ++q) {
                    float a[8];
#pragma unroll
                    for (int i = 0; i < 8; ++i) a[i] = v[i][q];
                    st8_bf16(p.BT + pkl(((long)b * 4 + g) * 128 + half * 64 + cg * 8 + q, t0, 256), a);
                }
            }
        }
        __syncthreads();
        return;
    }
}
DEV void phase2e5(CParams& p, int task, char* smem) {
    {
        const int g = task >> 1, mt = task & 1;
        GRow<4> al; al.initp(p.UG + (long)g * T_TOK * 16, 16, (long)mt * 256, false);
        GRow<2> bl; bl.initp(p.E5T + (long)g * 128 * 512, 16, 0, true);
        f32x4 acc[8][4]; zero_acc(acc);
        gemm_loop<true>(smem, al, bl, 16, acc);
        epi_rows(acc, [&](int r, int c0, const Row16& v) __attribute__((always_inline)) { st16_f32(p.E5 + ((long)g * 512 + mt * 256 + r) * 128 + c0, v); });
    }
}

constexpr int P3_ST = 256, P3_CARRY = 256, P3_TASKS = P3_ST + P3_CARRY;
DEV void phase3(CParams& p, int task, char* smem) {
    const int tid = TIDX;
    if (task < P3_ST) {
        const int g = task & 3, c = (task >> 2) & 31, b = task >> 7;
        GRow<4> al; al.initp(p.XDECT, 256, ((long)b * 16 + 4 * g) * 64, false, c * 8);
        GRow<2> bl; bl.initp(p.BT, 256, ((long)b * 4 + g) * 128, true, c * 8);
        f32x4 acc[8][4]; zero_acc(acc);
        gemm_loop<true>(smem, al, bl, 8, acc);
        float* dst = p.ST + ((((long)b * 32 + c) * 16 + 4 * g) * 64) * 128;
        epi_rows(acc, [&](int r, int c0, const Row16& v) __attribute__((always_inline)) { st16_f32(dst + (long)r * 128 + c0, v); });
        return;
    }
    task -= P3_ST;
    {
        const int nq = task & 3, g = (task >> 2) & 31, b = task >> 7;
        const int n = nq * 16 + (tid & 15), seg = tid >> 4;
        const float qr = p.AQ[(g * 64 + n) * 2], qi = p.AQ[(g * 64 + n) * 2 + 1];
        const float* e = p.E5 + ((long)g * 512 + b * 256 + seg * 16) * 128;
        float er[16], ei[16];
#pragma unroll
        for (int u = 0; u < 16; ++u) { er[u] = e[(long)u * 128 + n]; ei[u] = e[(long)u * 128 + 64 + n]; }
        float tr = 0.f, ti = 0.f;
#pragma unroll
        for (int u = 0; u < 16; ++u) {
            const float lr = tr, li = ti;
            const float nr = qr * tr - qi * ti + er[u], ni = qr * ti + qi * tr + ei[u];
            tr = nr; ti = ni; er[u] = lr; ei[u] = li;
        }
        float pr = qr, pi = qi;
#pragma unroll
        for (int s = 0; s < 4; ++s) { const float a = pr * pr - pi * pi, c2 = 2.f * pr * pi; pr = a; pi = c2; }
        float* sx = (float*)smem;
        sx[(seg * 16 + (tid & 15)) * 2] = tr; sx[(seg * 16 + (tid & 15)) * 2 + 1] = ti;
        __syncthreads();
        if (tid < 16) {
            float sr = 0.f, si = 0.f;
            for (int s = 0; s < 16; ++s) {
                const float t0 = sx[(s * 16 + tid) * 2], t1 = sx[(s * 16 + tid) * 2 + 1];
                sx[(s * 16 + tid) * 2] = sr; sx[(s * 16 + tid) * 2 + 1] = si;
                const float nr = pr * sr - pi * si + t0, ni = pr * si + pi * sr + t1;
                sr = nr; si = ni;
            }
        }
        __syncthreads();
        float sr = sx[(seg * 16 + (tid & 15)) * 2], si = sx[(seg * 16 + (tid & 15)) * 2 + 1];
        bf16_t* o = p.SPREV + (long)g * 512 * 128;
#pragma unroll
        for (int u = 0; u < 16; ++u) {
            const int row = b * 256 + seg * 16 + u;
            o[pkl(row, n, 4)] = f2bf(sr + er[u]); o[pkl(row, 64 + n, 4)] = f2bf(si + ei[u]);
            const float nr = qr * sr - qi * si, ni = qr * si + qi * sr;
            sr = nr; si = ni;
        }
        __syncthreads();
    }
}

constexpr int P4_SCAN = 256, P4_Y = 256, P4_TASKS = P4_SCAN + P4_Y;
DEV void phase4(CParams& p, int task, char* smem) {
    const int tid = TIDX;
    if (task < P4_SCAN) {
        const int id = task * 256 + tid, pn = (id & 2047) * 4, h = (id >> 11) & 15, b = id >> 15;
        f32x4 s = {0.f, 0.f, 0.f, 0.f};
        for (int c0 = 0; c0 < 32; c0 += 8) {
            f32x4 st[8]; float at[8];
#pragma unroll
            for (int u = 0; u < 8; ++u) {
                st[u] = *(const f32x4*)(p.ST + ((((long)b * 32 + c0 + u) * 16 + h) * 8192) + pn);
                at[u] = p.ACS[((long)b * 16 + h) * SEQ + (c0 + u) * 256 + 255];
            }
#pragma unroll
            for (int u = 0; u < 8; ++u) {
                u32x2 w; w.x = pack2(s[0], s[1]); w.y = pack2(s[2], s[3]);
                *(u32x2*)(p.PREV + ((((long)b * 32 + c0 + u) * 16 + h) * 8192) + pn) = w;
                s = __expf(at[u]) * s + st[u];
            }
        }
        return;
    }
    task -= P4_SCAN;
    {
        const int nt = task & 3, mt = (task >> 2) & 1, g = task >> 3;
        f32x4 acc[8][4]; zero_acc(acc);
        {
            GRow<4> al; al.initp(p.UG + (long)g * T_TOK * 16, 16, (long)mt * 256, false);
            GRow<2> bl; bl.initp(p.W5T + (long)g * 512 * 640, 20, (long)nt * 128, true);
            gemm_loop<true>(smem, al, bl, 4 * (nt + 1), acc);
        }
        {
            GRow<4> al; al.initp(p.SPREV + (long)g * 512 * 128, 4, (long)mt * 256, false);
            GRow<2> bl; bl.initp(p.W5T + (long)g * 512 * 640, 20, (long)nt * 128, true, 16);
            gemm_loop<true>(smem, al, bl, 4, acc);
        }
        epi_rows(acc, [&](int r, int c0, const Row16& v) __attribute__((always_inline)) {
            const int rr = mt * 256 + r, tp = (nt * 128 + c0) >> 4;
            const long t = (long)rr * 32 + tp;
            float u[16], d[16], o[16];
            ld16_bf16(p.UG + (long)g * T_TOK * 16 + pkl(t >> 5, (int)(t & 31) * 16, 16), u);
            ld16_f32(p.s5_d + g * 16, d);
#pragma unroll
            for (int q = 0; q < 16; ++q) o[q] = gelu_tanh(v.get(q) + d[q] * u[q]);
            st16_bf16(p.G5 + pkl(t, g * 16, 16), o);
        });
    }
}

constexpr int P5_SSD = 2048;
DEV void phase5(CParams& p, int task, char* smem) {
    const int tid = TIDX, lane = tid & 63, wid = tid >> 6, fr = lane & 15, fq = lane >> 4;
    if (task < P5_SSD) {
        const int half = task & 1, h = (task >> 1) & 15, c = (task >> 5) & 31, b = task >> 10, g = h >> 2;
        const int l0 = half * 128 + wid * 32;
        const long tok0 = (long)b * SEQ + c * 256;
        char* sB = smem;
        char* sX = smem + 17408;
        char* sM = smem + 17408 + 9216 + wid * 4608;
        float* sacs = (float*)(smem + 17408 + 9216 + 18432);
        sacs[tid] = p.ACS[((long)b * 16 + h) * SEQ + c * 256 + tid];
        bf16x8 cf[2][4];
#pragma unroll
        for (int mi = 0; mi < 2; ++mi)
#pragma unroll
            for (int ks = 0; ks < 4; ++ks) cf[mi][ks] = *(const bf16x8*)(p.CN + (tok0 + l0 + mi * 16 + fr) * 512 + g * 128 + ks * 32 + fq * 8);
        {
            const bf16_t* pv = p.PREV + ((((long)b * 32 + c) * 16 + h) * 64) * 128;
#pragma unroll
            for (int i = 0; i < 4; ++i) { const int q = tid + 256 * i, r = q >> 4, kc = q & 15; *(bf16x8*)(sB + r * 272 + kc * 16) = *(const bf16x8*)(pv + r * 128 + kc * 8); }
        }
        __syncthreads();
        f32x4 y[2][4];
#pragma unroll
        for (int mi = 0; mi < 2; ++mi)
#pragma unroll
            for (int np = 0; np < 4; ++np) y[mi][np] = (f32x4){0.f, 0.f, 0.f, 0.f};
#pragma unroll
        for (int ks = 0; ks < 4; ++ks)
#pragma unroll
            for (int np = 0; np < 4; ++np) {
                const bf16x8 pf = *(const bf16x8*)(sB + (np * 16 + fr) * 272 + ks * 64 + fq * 16);
#pragma unroll
                for (int mi = 0; mi < 2; ++mi) y[mi][np] = __builtin_amdgcn_mfma_f32_16x16x32_bf16(pf, cf[mi][ks], y[mi][np], 0, 0, 0);
            }
        float al[2];
#pragma unroll
        for (int mi = 0; mi < 2; ++mi) {
            al[mi] = sacs[l0 + mi * 16 + fr];
            const float e = __expf(al[mi]);
#pragma unroll
            for (int np = 0; np < 4; ++np) y[mi][np] *= e;
        }
        __syncthreads();
        const int nj = half * 2 + 2;
        bf16x8 rbB[4], rbX[2];
#pragma unroll
        for (int i = 0; i < 4; ++i) { const int q = tid + 256 * i, r = q >> 4, kc = q & 15; rbB[i] = *(const bf16x8*)(p.BN + (tok0 + r) * 512 + g * 128 + kc * 8); }
#pragma unroll
        for (int i = 0; i < 2; ++i) { const int q = tid + 256 * i, r = q >> 3, kc = q & 7; rbX[i] = *(const bf16x8*)(p.XDTT + (((long)b * 16 + h) * 64 + r) * SEQ + c * 256 + kc * 8); }
        for (int jb = 0; jb < nj; ++jb) {
#pragma unroll
            for (int i = 0; i < 4; ++i) { const int q = tid + 256 * i, r = q >> 4, kc = q & 15; *(bf16x8*)(sB + r * 272 + kc * 16) = rbB[i]; }
#pragma unroll
            for (int i = 0; i < 2; ++i) { const int q = tid + 256 * i, r = q >> 3, kc = q & 7; *(bf16x8*)(sX + r * 144 + kc * 16) = rbX[i]; }
            __syncthreads();
            if (jb + 1 < nj) {
#pragma unroll
                for (int i = 0; i < 4; ++i) { const int q = tid + 256 * i, r = q >> 4, kc = q & 15; rbB[i] = *(const bf16x8*)(p.BN + (tok0 + (jb + 1) * 64 + r) * 512 + g * 128 + kc * 8); }
#pragma unroll
                for (int i = 0; i < 2; ++i) { const int q = tid + 256 * i, r = q >> 3, kc = q & 7; rbX[i] = *(const bf16x8*)(p.XDTT + (((long)b * 16 + h) * 64 + r) * SEQ + c * 256 + (jb + 1) * 64 + kc * 8); }
            }
            if (jb * 64 <= l0 + 31) {
#pragma unroll
                for (int nh = 0; nh < 2; ++nh) {
                    f32x4 S[2][2];
#pragma unroll
                    for (int mi = 0; mi < 2; ++mi)
#pragma unroll
                        for (int n2 = 0; n2 < 2; ++n2) S[mi][n2] = (f32x4){0.f, 0.f, 0.f, 0.f};
#pragma unroll
                    for (int ks = 0; ks < 4; ++ks)
#pragma unroll
                        for (int n2 = 0; n2 < 2; ++n2) {
                            const bf16x8 bf = *(const bf16x8*)(sB + ((nh * 2 + n2) * 16 + fr) * 272 + ks * 64 + fq * 16);
#pragma unroll
                            for (int mi = 0; mi < 2; ++mi) S[mi][n2] = __builtin_amdgcn_mfma_f32_16x16x32_bf16(bf, cf[mi][ks], S[mi][n2], 0, 0, 0);
                        }
#pragma unroll
                    for (int n2 = 0; n2 < 2; ++n2) {
                        const int n = nh * 2 + n2, s0 = jb * 64 + n * 16 + fq * 4;
                        const f32x4 as4 = *(const f32x4*)(sacs + s0);
#pragma unroll
                        for (int mi = 0; mi < 2; ++mi) {
                            const int l = l0 + mi * 16 + fr;
                            float v[4];
#pragma unroll
                            for (int j = 0; j < 4; ++j) v[j] = (s0 + j <= l) ? S[mi][n2][j] * __expf(al[mi] - as4[j]) : 0.f;
                            u32x2 w; w.x = pack2(v[0], v[1]); w.y = pack2(v[2], v[3]);
                            *(u32x2*)(sM + (mi * 16 + fr) * 144 + (n * 16 + fq * 4) * 2) = w;
                        }
                    }
                }
                asm volatile("s_waitcnt lgkmcnt(0)" ::: "memory");
#pragma unroll
                for (int ks = 0; ks < 2; ++ks) {
                    bf16x8 mf[2];
#pragma unroll
                    for (int mi = 0; mi < 2; ++mi) mf[mi] = *(const bf16x8*)(sM + (mi * 16 + fr) * 144 + ks * 64 + fq * 16);
#pragma unroll
                    for (int np = 0; np < 4; ++np) {
                        const bf16x8 xf = *(const bf16x8*)(sX + (np * 16 + fr) * 144 + ks * 64 + fq * 16);
#pragma unroll
                        for (int mi = 0; mi < 2; ++mi) y[mi][np] = __builtin_amdgcn_mfma_f32_16x16x32_bf16(xf, mf[mi], y[mi][np], 0, 0, 0);
                    }
                }
            }
            __syncthreads();
        }
        const float Dh = p.ssd_d[h];
#pragma unroll
        for (int mi = 0; mi < 2; ++mi) {
            const long t = tok0 + l0 + mi * 16 + fr;
            float ss = 0.f;
#pragma unroll
            for (int np = 0; np < 4; ++np) {
                const int col = h * 64 + np * 16 + fq * 4;
                const u32x2 xr = *(const u32x2*)(p.XN + t * 1024 + col), zr = *(const u32x2*)(p.Z + t * 1024 + col);
                float o[4];
#pragma unroll
                for (int j = 0; j < 4; ++j) {
                    const unsigned xw = (j < 2) ? xr.x : xr.y, zw = (j < 2) ? zr.x : zr.y;
                    const float xv = bf2f((bf16_t)((j & 1) ? (xw >> 16) : (xw & 0xffffu))), zv = bf2f((bf16_t)((j & 1) ? (zw >> 16) : (zw & 0xffffu)));
                    o[j] = (y[mi][np][j] + Dh * xv) * siluf_(zv);
                    ss += o[j] * o[j];
                }
                u32x2 w; w.x = pack2(o[0], o[1]); w.y = pack2(o[2], o[3]);
                *(u32x2*)(p.YG + pkl(t, col, 32)) = w;
            }
            ss = sum_fq(ss);
            if (fq == 0) p.SSQ[t * 16 + h] = ss;
        }
        return;
    }
}
DEV void phase5glu(CParams& p, int mt, int nt, char* smem) {
    {
        GRow<4> al; al.initp(p.G5, 16, (long)mt * 256, false);
        GRow<2> bl; bl.initp(p.WGLUT, 16, (long)nt * 128, true);
        f32x4 acc[8][4]; zero_acc(acc);
        gemm_loop(smem, al, bl, 16, acc);
        epi_rows(acc, [&](int r, int c0, const Row16& v) __attribute__((always_inline)) {
            const long t = (long)mt * 256 + r; const int col = nt * 128 + c0;
            float gv[16], bb[16], o[16];
            ld16_bf16(p.G5 + pkl(t, col, 16), gv);
            ld16_f32(p.b_glu + col, bb);
            float ss = 0.f;
#pragma unroll
            for (int q = 0; q < 16; ++q) { o[q] = gv[q] * sigmoidf_(v.get(q) + bb[q]); ss += o[q] * o[q]; }
            st16_bf16(p.Y5 + pkl(t, col, 16), o);
            ss = sum_fq(ss);
            if ((TIDX & 63) < 16) p.SSQ[(long)T_TOK * 16 + t * 8 + nt * 2 + (c0 >> 6)] = ss;
        });
    }
}

constexpr int P6_TASKS = 64 * 8;
DEV void phase6(CParams& p, int mt, int nt, char* smem) {
    float* srs = (float*)(smem + GEMM_SMEM);
    {
        const int r = TIDX; const long t = (long)mt * 256 + r;
        float s1 = 0.f, s2 = 0.f;
#pragma unroll
        for (int q = 0; q < 16; ++q) s1 += p.SSQ[t * 16 + q];
#pragma unroll
        for (int q = 0; q < 8; ++q) s2 += p.SSQ[(long)T_TOK * 16 + t * 8 + q];
        const float r1 = rsqrtf(s1 * (1.f / 1024.f) + 1e-6f), r2 = rsqrtf(s2 * (1.f / 512.f) + 1e-6f);
        srs[r] = r1 / r2; srs[256 + r] = r2;
    }
    __syncthreads();
    f32x4 acc[8][4]; zero_acc(acc);
    {
        GRow<4> al; al.initp(p.YG, 32, (long)mt * 256, false);
        GRow<2> bl; bl.initp(p.WOUTT, 48, (long)nt * 128, true);
        gemm_loop<true>(smem, al, bl, 32, acc);
    }
    {
        const int lane = TIDX & 63, wr = TIDX >> 7, fr = lane & 15;
#pragma unroll
        for (int m = 0; m < 8; ++m) {
            const float sc = srs[wr * 128 + m * 16 + fr];
#pragma unroll
            for (int n = 0; n < 4; ++n) acc[m][n] *= sc;
        }
    }
    {
        GRow<4> al; al.initp(p.Y5, 16, (long)mt * 256, false);
        GRow<2> bl; bl.initp(p.WOUTT, 48, (long)nt * 128, true, 32);
        gemm_loop<true>(smem, al, bl, 16, acc);
    }
    epi_rows(acc, [&](int r, int c0, const Row16& v) __attribute__((always_inline)) {
        const long t = (long)mt * 256 + r; const int col = nt * 128 + c0, b = (int)(t >> 13);
        const float r2 = srs[256 + r];
        float xv[16], gv[16], o[16];
        ld16_f32(p.x + t * 1024 + col, xv);
        ld16_f32(p.MOD + b * 6144 + 2048 + col, gv);
        float ss = 0.f;
#pragma unroll
        for (int q = 0; q < 16; ++q) { o[q] = xv[q] + gv[q] * (v.get(q) * r2); ss += o[q] * o[q]; }
        st16_f32(p.X1 + t * 1024 + col, o);
        ss = sum_fq(ss);
        if ((TIDX & 63) < 16) p.SSQ[(long)T_TOK * 24 + t * 16 + nt * 2 + (c0 >> 6)] = ss;
    });
    __syncthreads();
}

constexpr int P7_TASKS = T_TOK / 4;
DEV void phase7(CParams& p, int task) {
    const int row = task * 4 + (TIDX >> 6), b = row >> 13;
    modnorm_row(p.X1, row, p.norm2_gain, p.MOD + b * 6144 + 4096, p.MOD + b * 6144 + 3072, p.SSQ + (long)T_TOK * 24, p.H, p.H2F8);
}

constexpr int P8_R = 128, P8_S = 256, P8_TASKS = P8_R + P8_S;
DEV void phase8r(CParams& p, int mt, int nt, char* smem) {
    GRow<4> al; al.initp(p.H, 32, (long)mt * 256, false);
    GRow<2> bl; bl.initp(p.WRT, 32, (long)nt * 128, true);
    f32x4 acc[8][4]; zero_acc(acc);
    gemm_loop<true>(smem, al, bl, 32, acc);
    epi_rows(acc, [&](int r, int c0, const Row16& v) __attribute__((always_inline)) {
        float o[16];
#pragma unroll
        for (int q = 0; q < 16; ++q) o[q] = sigmoidf_(v.get(q));
        st16_f32(p.SCORES + ((long)mt * 256 + r) * 256 + nt * 128 + c0, o);
    });
}
DEV void phase8s(CParams& p, int mt, int nt, char* smem) {
    GRow<4> al; al.initp(p.H, 32, (long)mt * 256, false);
    GRow<2> bl; bl.initp(p.WSUPT, 32, (long)nt * 128, false);
    f32x4 acc[8][4]; zero_acc(acc);
    gemm_loop<true>(smem, al, bl, 32, acc);
    epi_rows(acc, [&](int r, int c0, const Row16& v) __attribute__((always_inline)) {
        float o[8];
#pragma unroll
        for (int q = 0; q < 8; ++q) o[q] = siluf_(v.get(q)) * v.get(8 + q);
        st8_bf16(p.HSH + pkl((long)mt * 256 + r, nt * 64 + (c0 >> 1), 8), o);
    });
}
DEV void phase8(CParams& p, char* smem) {
    const int x = blockIdx.x & 7, member = blockIdx.x >> 3, nmem = (gridDim.x - x + 7) >> 3;
    for (int j = member; j < 48; j += nmem) {
        if (j < 16) phase8r(p, x * 8 + (j & 7), j >> 3, smem);
        else phase8s(p, x * 8 + ((j - 16) & 7), (j - 16) >> 3, smem);
    }
}

constexpr int P9_TASKS = T_TOK / 32;
DEV void phase9(CParams& p, int task) {
    const int lane = TIDX & 63, t0 = (task * 4 + (TIDX >> 6)) * 8;
    int accE = 0; float accW = 0.f;
    const f32x4 bs = *(const f32x4*)(p.router_bias + lane * 4);
#pragma unroll 2
  for (int ti = 0; ti < 8; ++ti) {
    const int t = t0 + ti;
    const f32x4 s = *(const f32x4*)(p.SCORES + (long)t * 256 + lane * 4);
    float v0 = s[0] + bs[0], v1 = s[1] + bs[1], v2 = s[2] + bs[2], v3 = s[3] + bs[3];
    float m1, m2;
    { const float a = fmaxf(v0, v1), b = fminf(v0, v1), c = fmaxf(v2, v3), d = fminf(v2, v3); m1 = fmaxf(a, c); m2 = fmaxf(fminf(a, c), fmaxf(b, d)); }
#pragma unroll
    for (int off = 1; off <= 4; off <<= 1) {
        const float o1 = __shfl_xor(m1, off), o2 = __shfl_xor(m2, off);
        const float n1 = fmaxf(m1, o1), n2 = fmaxf(fminf(m1, o1), fmaxf(m2, o2));
        m1 = n1; m2 = n2;
    }
    const float gs = m1 + m2;
    const int myg = lane >> 3;
    int rank = 0;
#pragma unroll
    for (int j = 0; j < 8; ++j) { const float og = __shfl(gs, j * 8); rank += ((og > gs) || (og == gs && j < myg)) ? 1 : 0; }
    const float NEG = -__builtin_inff();
    if (rank >= 4) { v0 = NEG; v1 = NEG; v2 = NEG; v3 = NEG; }
    float wsum = 0.f, myS = 0.f; int myE = 0;
#pragma unroll
    for (int r = 0; r < 8; ++r) {
        float bv = v0; int bi = 0;
        if (v1 > bv) { bv = v1; bi = 1; }
        if (v2 > bv) { bv = v2; bi = 2; }
        if (v3 > bv) { bv = v3; bi = 3; }
        float rv = bv; int ri = lane * 4 + bi;
#pragma unroll
        for (int off = 32; off >= 1; off >>= 1) {
            const float ov = __shfl_xor(rv, off); const int oi = __shfl_xor(ri, off);
            if (ov > rv || (ov == rv && oi < ri)) { rv = ov; ri = oi; }
        }
        const int sel = ri & 3;
        const float ssel = (sel == 0) ? s[0] : (sel == 1) ? s[1] : (sel == 2) ? s[2] : s[3];
        const float sc = __shfl(ssel, ri >> 2);
        if ((ri >> 2) == lane) { if (sel == 0) v0 = NEG; else if (sel == 1) v1 = NEG; else if (sel == 2) v2 = NEG; else v3 = NEG; }
        if (lane == r) { myE = ri; myS = sc; }
        wsum += sc;
    }
    const float w = myS / wsum * 2.5f;
    const int eS = __shfl(myE, lane & 7); const float wS = __shfl(w, lane & 7);
    if ((lane >> 3) == ti) { accE = eS; accW = wS; }
  }
    {
        const int t = t0 + (lane >> 3), k = lane & 7;
        int pos = atomicAdd(&p.CNT[accE], 1);
        pos = pos < 0 ? 0 : (pos >= CAP ? CAP - 1 : pos);
        p.BTOK[(long)accE * CAP + pos] = t;
        p.ASG_E[t * 8 + k] = accE; p.ASG_P[t * 8 + k] = pos; p.ASG_W[t * 8 + k] = accW;
    }
}

DEV int pos_of_expert(int e) { return (e & 7) * 32 + (e >> 3); }
DEV int expert_of_pos(int q) { return (q & 31) * 8 + (q >> 5); }
DEV void build_tables(CParams& p, int* tab, int* scratch) {
    const int tid = TIDX;
    const int c = p.CNT[expert_of_pos(tid)];
    int* a = scratch; int* b2 = scratch + 256;
    a[tid] = (c + XM - 1) / XM; b2[tid] = c;
    __syncthreads();
    for (int off = 1; off < 256; off <<= 1) {
        const int va = (tid >= off) ? a[tid - off] : 0, vb = (tid >= off) ? b2[tid - off] : 0;
        __syncthreads();
        a[tid] += va; b2[tid] += vb;
        __syncthreads();
    }
    tab[tid + 1] = a[tid]; tab[257 + tid + 1] = b2[tid];
    if (tid == 0) { tab[0] = 0; tab[257] = 0; }
    __syncthreads();
}
DEV int rows_per_tile(int cnt, int tiles) { return (((cnt + tiles - 1) / tiles) + 31) & ~31; }
DEV void find_unit(const int* tab, int x, int NT, int u, int& q, int& nt, int& rt) {
    const int base = tab[32 * x];
    int lo = 32 * x, hi = 32 * x + 31;
    while (lo < hi) { const int mid = (lo + hi + 1) >> 1; if (NT * (tab[mid] - base) <= u) lo = mid; else hi = mid - 1; }
    q = lo;
    const int local = u - NT * (tab[q] - base), tiles = tab[q + 1] - tab[q];
    nt = local / tiles; rt = local - nt * tiles;
}

DEV void phase10(CParams& p, char* smem, bool rep) {
    int* tab = (int*)(smem + GEMM_SMEM);
    build_tables(p, tab, (int*)smem);
    const int x0 = blockIdx.x & 7;
    for (int gi = 0; gi < 8; ++gi) {
      const int x = (x0 + gi) & 7; unsigned* qh = q_head(p, 2, rep, x);
      const int U = 4 * (tab[32 * x + 32] - tab[32 * x]);
      for (;;) {
        const int u = dq_next(qh, smem); if (u >= U) break;
        int q, nt, rt; find_unit(tab, x, 4, u, q, nt, rt);
        const int e = expert_of_pos(q);
        const int cnt = tab[257 + q + 1] - tab[257 + q], rpt = rows_per_tile(cnt, tab[q + 1] - tab[q]);
        const int row0 = rt * rpt, s0 = tab[257 + q] + row0, valid = min(rpt, cnt - row0);
        XGather al; al.base = (const char*)p.H2F8; al.kstb = 64u;
        {
            const int kcs = gather_kcs();
#pragma unroll
            for (int i = 0; i < 5; ++i) { const int r = (TIDX >> 2) + 64 * i; const int tok = (r < valid) ? p.BTOK[(long)e * CAP + row0 + r] : 0; al.off[i] = (unsigned)tok * 1024u + (unsigned)kcs * 2u; }
        }
        int mat, jcol; up_row_map(nt, (TIDX & 31) * 4, mat, jcol);
        ColF8<256> bl; bl.colp = (mat ? p.w3 : p.w1) + (long)e * 262144 + jcol;
        f32x4 acc[10][4]; zero_acc10(acc);
        gemm_loop_x8(smem, al, bl, 16, valid, acc);
        unsigned char* hid_dst = rep ? (unsigned char*)p.OUTR : (unsigned char*)p.HID;
        epi_rows10(acc, [&](int r, int c0, const Row16& v) __attribute__((always_inline)) {
            if (r < valid) {
                float o[8];
#pragma unroll
                for (int qq = 0; qq < 8; ++qq) o[qq] = siluf_(v.get(qq) * W8_INV) * (v.get(8 + qq) * W8_INV);
                u32x2 w8; w8.x = pack4_fp8(o[0], o[1], o[2], o[3]); w8.y = pack4_fp8(o[4], o[5], o[6], o[7]);
                *(u32x2*)(hid_dst + pkl8(s0 + r, nt * 64 + (c0 >> 1), 4)) = w8;
            }
        });
      }
    }
}

DEV void phase10b(CParams& p, char* smem) {
    for (int idx = 0;; ++idx) {
        int mt, nt; if (!xcd_tile(idx, 64, 8, mt, nt)) break;
        GRow<4> al; al.initp(p.HSH, 8, (long)mt * 256, false);
        GRow<2> bl; bl.initp(p.WS2T, 8, (long)nt * 128, true);
        f32x4 acc[8][4]; zero_acc(acc);
        gemm_loop<true>(smem, al, bl, 8, acc);
        epi_rows(acc, [&](int r, int c0, const Row16& v) __attribute__((always_inline)) {
            const long t = (long)mt * 256 + r; const int col = nt * 128 + c0, b = (int)(t >> 13);
            float xv[16], gv[16], o[16];
            ld16_f32(p.X1 + t * 1024 + col, xv);
            ld16_f32(p.MOD + b * 6144 + 5120 + col, gv);
#pragma unroll
            for (int qq = 0; qq < 16; ++qq) o[qq] = xv[qq] + gv[qq] * v.get(qq);
            st16_f32(p.X1 + t * 1024 + col, o);
        });
    }
}

DEV void phase11(CParams& p, char* smem, bool rep) {
    int* tab = (int*)(smem + GEMM_SMEM);
    build_tables(p, tab, (int*)smem);
    const int x0 = blockIdx.x & 7;
    for (int gi = 0; gi < 8; ++gi) {
      const int x = (x0 + gi) & 7; unsigned* qh = q_head(p, 3, rep, x);
      const int U = 8 * (tab[32 * x + 32] - tab[32 * x]);
      for (;;) {
        const int u = dq_next(qh, smem); if (u >= U) break;
        int q, nt, rt; find_unit(tab, x, 8, u, q, nt, rt);
        const int e = expert_of_pos(q);
        const int cnt = tab[257 + q + 1] - tab[257 + q], rpt = rows_per_tile(cnt, tab[q + 1] - tab[q]);
        const int row0 = rt * rpt, s0 = tab[257 + q] + row0, valid = min(rpt, cnt - row0);
        XGather al; al.base = (const char*)p.HID; al.kstb = 128u;
        {
            const int kcs = gather_kcs();
#pragma unroll
            for (int i = 0; i < 5; ++i) al.off[i] = (unsigned)pkl8(s0 + (int)(TIDX >> 2) + 64 * i, 0, 4) + (unsigned)kcs * 2u;
        }
        ColF8<1024> bl; bl.colp = p.w2 + (long)e * 262144 + nt * 128 + bcol((TIDX & 31) * 4);
        f32x4 acc[10][4]; zero_acc10(acc);
        gemm_loop_x8(smem, al, bl, 4, valid, acc);
        epi_rows10(acc, [&](int r, int c0, const Row16& v) __attribute__((always_inline)) {
            if (r < valid) {
                const f32x4 s0v = v.a0 * W8_INV, s1v = v.a1 * W8_INV, s2v = v.a2 * W8_INV, s3v = v.a3 * W8_INV;
                u32x4 w8; w8.x = pack4_fp8(s0v[0], s0v[1], s0v[2], s0v[3]); w8.y = pack4_fp8(s1v[0], s1v[1], s1v[2], s1v[3]);
                w8.z = pack4_fp8(s2v[0], s2v[1], s2v[2], s2v[3]); w8.w = pack4_fp8(s3v[0], s3v[1], s3v[2], s3v[3]);
                *(u32x4*)((unsigned char*)p.OUTR + (long)(s0 + r) * 1024 + nt * 128 + c0) = w8;
            }
        });
      }
    }
}

DEV void phase12(CParams& p, char* smem) {
    int* tab = (int*)(smem + GEMM_SMEM);
    build_tables(p, tab, (int*)smem);
    const int lane = TIDX & 63;
    for (int task = blockIdx.x; task < T_TOK / 4; task += gridDim.x) {
        const int t = task * 4 + (TIDX >> 6), b = t >> 13;
        float a[16];
#pragma unroll
        for (int i = 0; i < 16; ++i) a[i] = 0.f;
#pragma unroll
        for (int k = 0; k < 8; ++k) {
            const int e = p.ASG_E[t * 8 + k], pos = p.ASG_P[t * 8 + k];
            const float w = p.ASG_W[t * 8 + k];
            const unsigned char* row = (const unsigned char*)p.OUTR + (long)(tab[257 + pos_of_expert(e)] + pos) * 1024;
            const u32x4 v = *(const u32x4*)(row + lane * 16);
#pragma unroll
            for (int q = 0; q < 4; ++q) {
                const unsigned wd = (q == 0) ? v.x : (q == 1) ? v.y : (q == 2) ? v.z : v.w;
                const f32x2 lo = __builtin_amdgcn_cvt_pk_f32_fp8((int)wd, false), hi = __builtin_amdgcn_cvt_pk_f32_fp8((int)wd, true);
                a[q * 4 + 0] += w * lo[0]; a[q * 4 + 1] += w * lo[1]; a[q * 4 + 2] += w * hi[0]; a[q * 4 + 3] += w * hi[1];
            }
        }
        const int c0 = lane * 16;
        float ss = 0.f;
#pragma unroll
        for (int q4 = 0; q4 < 4; ++q4) {
            const f32x4 x0 = *(const f32x4*)(p.X1 + (long)t * 1024 + c0 + q4 * 4);
            const f32x4 g0 = *(const f32x4*)(p.MOD + b * 6144 + 5120 + c0 + q4 * 4);
#pragma unroll
            for (int q = 0; q < 4; ++q) { a[q4 * 4 + q] = x0[q] + g0[q] * a[q4 * 4 + q]; ss += a[q4 * 4 + q] * a[q4 * 4 + q]; }
        }
        ss = wave_sum(ss);
        const float rstd = rsqrtf(ss * (1.f / 1024.f) + 1e-6f);
#pragma unroll
        for (int q4 = 0; q4 < 4; ++q4) {
            const f32x4 g0 = *(const f32x4*)(p.final_gain + c0 + q4 * 4);
            f32x4 o0;
#pragma unroll
            for (int q = 0; q < 4; ++q) o0[q] = a[q4 * 4 + q] * rstd * g0[q];
            *(f32x4*)(p.out + (long)t * 1024 + c0 + q4 * 4) = o0;
        }
    }
}

DEV void run_p1(CParams& p, char* smem, bool rep) {
    const int x0 = blockIdx.x & 7;
    for (int gi = 0; gi < 8; ++gi) {
        const int x = (x0 + gi) & 7; unsigned* q = q_head(p, 0, rep, x);
        for (;;) { const int j = dq_next(q, smem); if (j >= 8 * 29) break; phase1(p, x * 8 + (j & 7), j >> 3, smem, rep); }
    }
    if (!rep) { unsigned* q = q_head(p, 5, rep, 0); for (;;) { const int j = dq_next(q, smem); if (j >= P0B_TOEP) break; phase0b_toep(p, j); } }
}
DEV void run_p0(CParams& p, char* smem, bool rep) {
    unsigned* modcnt = q_head(p, 4, rep, 0);
    for (int t = blockIdx.x; t < P0_TASKS; t += gridDim.x) phase0(p, t, smem, modcnt);
    __syncthreads();
    if (TIDX == 0) {
        unsigned sp = 0;
        while (__hip_atomic_load(modcnt, __ATOMIC_RELAXED, __HIP_MEMORY_SCOPE_AGENT) < (unsigned)P0_MOD) { __builtin_amdgcn_s_sleep(2); if (++sp > (1u << 22)) break; }
        __builtin_amdgcn_fence(__ATOMIC_ACQUIRE, "agent");
        asm volatile("s_waitcnt vmcnt(0)" ::: "memory");
    }
    __syncthreads();
    for (int t = blockIdx.x; t < P0B_ROWS; t += gridDim.x) phase0b_rows(p, t);
}
DEV void run_p5(CParams& p, char* smem, bool rep) {
    {
        unsigned* q = q_head(p, 1, rep, 0);
        for (;;) { const int j = dq_next(q, smem); if (j >= P5_SSD) break; phase5(p, ((j & 1023) << 1) | ((j >> 10) ^ 1), smem); }
    }
    {
        unsigned* q = q_head(p, 1, rep, 1);
        for (;;) { const int g = dq_next(q, smem); if (g >= 256) break; phase5glu(p, g >> 2, g & 3, smem); }
    }
}
DEV void run_p2(CParams& p, char* smem) {
    for (int t = blockIdx.x; t < P2_CONV; t += gridDim.x) phase2(p, t, smem);
    for (int t = blockIdx.x; t < P2_E; t += gridDim.x) phase2e5(p, t, smem);
}
DEV void run_p6(CParams& p, char* smem) { for (int i = 0;; ++i) { int mt, nt; if (!xcd_tile(i, 64, 8, mt, nt)) break; phase6(p, mt, nt, smem); } }

__global__ void __launch_bounds__(256, 2) fwd_kernel(Params p0) {
    extern __shared__ __attribute__((aligned(16))) char smem[];
    const bool multi = (p0.phase_hi - p0.phase_lo) > 1;
    if (multi) {
        if (TIDX == 0) { *(uint4*)(smem + SMEM_BYTES - 16) = make_uint4(0u, 0u, 0u, 0u); }
        __syncthreads();
        (void)xcd_barrier_post(p0.bar, (volatile LAS unsigned*)(smem + SMEM_BYTES - 16));
    }
#define XB_NOW() ({ XcdBarrier xb_; xb_.bar = ((CParams*)__builtin_amdgcn_kernarg_segment_ptr())->bar; xb_.x = xb_xcc_id(); xb_.st = (volatile LAS unsigned*)(smem + SMEM_BYTES - 16); xb_; })
    const int lo = p0.phase_lo, hi = p0.phase_hi, rp_ = p0.repeat_phase;
#define PH_RUN(n, body) if (lo <= (n) && (n) < hi) { const int nrep_ = ((n) == rp_) ? 2 : 1; for (int rep_ = 0; rep_ < nrep_; ++rep_) { if ((n) > lo || rep_ > 0) xcd_barrier(XB_NOW()); const bool rep = rep_ > 0; (void)rep; CParams* pp_ = (CParams*)__builtin_amdgcn_kernarg_segment_ptr(); asm volatile("" : "+s"(pp_)); CParams& p = *pp_; body } }
    PH_RUN(0, run_p0(p, smem, rep);)
    PH_RUN(2, run_p1(p, smem, rep);)
    PH_RUN(3, run_p2(p, smem);)
    PH_RUN(4, for (int t = blockIdx.x; t < P3_TASKS; t += gridDim.x) phase3(p, t, smem);)
    PH_RUN(5, for (int t = blockIdx.x; t < P4_TASKS; t += gridDim.x) phase4(p, t, smem);)
    PH_RUN(6, run_p5(p, smem, rep);)
    PH_RUN(7, run_p6(p, smem);)
    PH_RUN(8, for (int t = blockIdx.x; t < P7_TASKS; t += gridDim.x) phase7(p, t);)
    PH_RUN(9, phase8(p, smem);)
    PH_RUN(10, for (int t = blockIdx.x; t < P9_TASKS; t += gridDim.x) phase9(p, t);)
    PH_RUN(11, phase10(p, smem, rep); if (!rep) { CParams* q_ = (CParams*)__builtin_amdgcn_kernarg_segment_ptr(); asm volatile("" : "+s"(q_)); phase10b(*q_, smem); })
    PH_RUN(12, phase11(p, smem, rep);)
    PH_RUN(13, phase12(p, smem);)
}
constexpr int N_PH = 14;
static inline size_t al256(size_t v) { return (v + 255) & ~(size_t)255; }
extern "C" void kernel_launch(void* const* d_in, const int* in_sizes, int n_in, void* d_out, int out_size, void* d_ws, size_t ws_size, hipStream_t stream) {
    (void)in_sizes; (void)n_in; (void)out_size;
    Params p;
    ::memset((void*)&p, 0, sizeof(p));
    const float** ins = (const float**)&p.x;
    for (int i = 0; i < 34; ++i) ins[i] = (const float*)d_in[i];
    p.out = (float*)d_out;
    char* w = (char*)d_ws; size_t o = 0;
    auto carve = [&](size_t bytes) __attribute__((always_inline)) { char* r = w + o; o = al256(o + bytes); return r; };
    p.bar = (unsigned*)carve((XCD_BAR_WORDS + Q_WORDS) * 4);
    p.MOD = (float*)carve(2 * 6144 * 4);
    p.H = (bf16_t*)carve((size_t)T_TOK * 1024 * 2);
    p.WINT = (bf16_t*)carve((size_t)NPROJ_PAD * 1024 * 2);
    p.WOUTT = (bf16_t*)carve((size_t)1024 * 1536 * 2);
    p.WGLUT = (bf16_t*)carve((size_t)512 * 512 * 2);
    p.WRT = (bf16_t*)carve((size_t)256 * 1024 * 2);
    p.WSUPT = (bf16_t*)carve((size_t)512 * 1024 * 2);
    p.WS2T = (bf16_t*)carve((size_t)1024 * 256 * 2);
    p.KERN = (float*)carve((size_t)32 * 32 * 256 * 4);
    p.W5T = (bf16_t*)carve((size_t)32 * 512 * 640 * 2);
    p.E5T = (bf16_t*)carve((size_t)32 * 128 * 512 * 2);
    p.AQ = (float*)carve((size_t)32 * 64 * 2 * 4);
    p.Z = (bf16_t*)carve((size_t)T_TOK * 1024 * 2);
    p.XBCR = (bf16_t*)carve((size_t)T_TOK * 2048 * 2);
    p.DTR = (float*)carve((size_t)T_TOK * 16 * 4);
    p.UG = (bf16_t*)carve((size_t)32 * T_TOK * 16 * 2);
    p.XN = (bf16_t*)carve((size_t)T_TOK * 1024 * 2);
    p.BN = (bf16_t*)carve((size_t)T_TOK * 512 * 2);
    p.CN = (bf16_t*)carve((size_t)T_TOK * 512 * 2);
    p.XDTT = (bf16_t*)carve((size_t)T_TOK * 1024 * 2);
    p.XDECT = (bf16_t*)carve((size_t)T_TOK * 1024 * 2);
    p.BT = (bf16_t*)carve((size_t)T_TOK * 512 * 2);
    p.ACS = (float*)carve((size_t)2 * 16 * SEQ * 4);
    p.ST = (float*)carve((size_t)2 * 32 * 16 * 64 * 128 * 4);
    p.PREV = (bf16_t*)carve((size_t)2 * 32 * 16 * 64 * 128 * 2);
    p.E5 = (float*)carve((size_t)32 * 512 * 128 * 4);
    p.SPREV = (bf16_t*)carve((size_t)32 * 512 * 128 * 2);
    p.G5 = (bf16_t*)carve((size_t)T_TOK * 512 * 2);
    p.Y5 = (bf16_t*)carve((size_t)T_TOK * 512 * 2);
    p.YG = (bf16_t*)carve((size_t)T_TOK * 1024 * 2);
    p.SSQ = (float*)carve((size_t)T_TOK * 40 * 4);
    p.CNT = (int*)carve(256 * 4);
    p.X1 = (float*)carve((size_t)T_TOK * 1024 * 4);
    p.SCORES = (float*)carve((size_t)T_TOK * 256 * 4);
    p.BTOK = (int*)carve((size_t)NEXP * CAP * 4);
    p.ASG_E = (int*)carve((size_t)T_TOK * 8 * 4);
    p.ASG_P = (int*)carve((size_t)T_TOK * 8 * 4);
    p.ASG_W = (float*)carve((size_t)T_TOK * 8 * 4);
    p.HSH = (bf16_t*)carve((size_t)T_TOK * 256 * 2);
    p.HID = (bf16_t*)carve((size_t)(NSLOT + 320) * 256 * 2);
    p.H2F8 = (unsigned char*)carve((size_t)T_TOK * 1024);
    p.OUTR = (bf16_t*)carve((size_t)(NSLOT + 320) * 1024 * 2);
    p.DBG = (float*)carve(1024);
    if (o > ws_size) { fprintf(stderr, "workspace too small: need %zu have %zu\n", o, ws_size); return; }

    static int grid_blocks = 0;
    if (!grid_blocks) {
        int dev = 0, cus = 0, per_cu = 0;
        if (hipGetDevice(&dev) != hipSuccess || hipDeviceGetAttribute(&cus, hipDeviceAttributeMultiprocessorCount, dev) != hipSuccess) { fprintf(stderr, "kernel_launch: device query failed\n"); grid_blocks = -1; return; }
        if (hipFuncSetAttribute((const void*)fwd_kernel, hipFuncAttributeMaxDynamicSharedMemorySize, SMEM_BYTES) != hipSuccess) { fprintf(stderr, "kernel_launch: hipFuncSetAttribute failed\n"); grid_blocks = -1; return; }
        if (hipOccupancyMaxActiveBlocksPerMultiprocessor(&per_cu, (const void*)fwd_kernel, 256, SMEM_BYTES) != hipSuccess || per_cu < 1) { fprintf(stderr, "kernel_launch: occupancy query says %d\n", per_cu); per_cu = 1; }
        (void)hipGetLastError();
        if (per_cu > 2) per_cu = 2;
        grid_blocks = cus * per_cu;
    }
    if (grid_blocks < 0) return;
#if MULTI_LAUNCH
    (void)hipMemsetAsync(p.bar, 0, (XCD_BAR_WORDS + Q_WORDS) * 4, stream);
    for (int ph = 0; ph < N_PH && ph < MAX_PHASE; ++ph) {
        p.phase_lo = ph; p.phase_hi = ph + 1; p.repeat_phase = -1;
        hipLaunchKernelGGL(fwd_kernel, dim3(grid_blocks), dim3(256), SMEM_BYTES, stream, p);
    }
#else
    (void)hipMemsetAsync(p.bar, 0, (XCD_BAR_WORDS + Q_WORDS) * 4, stream);
    p.phase_lo = 0; p.phase_hi = N_PH; p.repeat_phase = REPEAT_PHASE;
    hipLaunchKernelGGL(fwd_kernel, dim3(grid_blocks), dim3(256), SMEM_BYTES, stream, p);
#endif
}
```
